# Optimizing an MI355X kernel written in HIP

```python
import jax, jax.numpy as jnp
from jax import lax
import numpy as np

D_MODEL = 1024
BATCH = 16
SEQ = 2048
DEPTH = 1

LRU_WIDTH = D_MODEL
LRU_BLOCKS = 8
LRU_BLOCK_DIM = LRU_WIDTH // LRU_BLOCKS
CONV_WIDTH = 4
LRU_C = 8.0
HG_WIDTH = D_MODEL
HG_EXPAND = 128
HG_HEADS = HG_WIDTH // HG_EXPAND
HG_HEAD_V = HG_WIDTH // HG_HEADS
CHUNK = 64
HG_SCALE = HG_EXPAND ** -0.5
N_BRANCH = 2
EPS = 1e-6
IN_COLS = 2 * LRU_WIDTH + 4 * HG_WIDTH + N_BRANCH * D_MODEL
SPLITS = [LRU_WIDTH, 2 * LRU_WIDTH, 2 * LRU_WIDTH + HG_WIDTH, 2 * LRU_WIDTH + 2 * HG_WIDTH,
          2 * LRU_WIDTH + 3 * HG_WIDTH, 2 * LRU_WIDTH + 4 * HG_WIDTH]

kernel_name = "hybrid_hawk_hgrn2_gated_block"


def rms_norm(x, g):
    xf = x.astype(jnp.float32)
    y = xf * lax.rsqrt(jnp.mean(xf * xf, axis=-1, keepdims=True) + EPS)
    return y.astype(x.dtype) * g


def causal_depthwise_conv(x, w, b):
    s = x.shape[1]
    xp = jnp.pad(x, ((0, 0), (CONV_WIDTH - 1, 0), (0, 0)))
    return b + sum(xp[:, k:k + s] * w[k] for k in range(CONV_WIDTH))


def block_diag_linear(x, w, b):
    bsz, s, _ = x.shape
    xb = x.reshape(bsz, s, LRU_BLOCKS, LRU_BLOCK_DIM)
    y = jnp.einsum('bshi,hij->bshj', xb, w) + b
    return y.reshape(bsz, s, LRU_WIDTH)


def _linear_recurrence_combine(left, right):
    a_l, u_l = left
    a_r, u_r = right
    return a_l * a_r, a_r * u_l + u_r


def rg_lru(x, wx, bx, wa, ba, lam):
    xf = x.astype(jnp.float32)
    gate_i = jax.nn.sigmoid(block_diag_linear(xf, wx, bx))
    gate_r = jax.nn.sigmoid(block_diag_linear(xf, wa, ba))
    log_a = -LRU_C * gate_r * jax.nn.softplus(-lam.astype(jnp.float32))
    a = jnp.exp(log_a)
    mult = jnp.sqrt(-jnp.expm1(2.0 * log_a))
    u = mult * gate_i * xf
    _, h = lax.associative_scan(_linear_recurrence_combine, (a, u), axis=1)
    return h.astype(x.dtype)


def hgrn2_chunked(q, k, v, log_f):
    bsz, s, h, dk = q.shape
    dv = v.shape[-1]
    n = s // CHUNK

    def to_chunks(t):
        return t.reshape(bsz, n, CHUNK, h, t.shape[-1]).transpose(1, 0, 3, 2, 4)

    q, k, v, log_f = map(to_chunks, (q, k, v, log_f))
    b = jnp.cumsum(log_f, axis=3)
    b_mid = b[:, :, :, CHUNK // 2:CHUNK // 2 + 1]
    b_last = b[:, :, :, -1:]
    q_in = q * jnp.exp(b - b_mid) * HG_SCALE
    k_in = k * jnp.exp(b_mid - b)
    causal = jnp.tril(jnp.ones((CHUNK, CHUNK), dtype=bool))
    att = jnp.where(causal, jnp.einsum('nbhtd,nbhsd->nbhts', q_in, k_in), 0.0)
    o_intra = jnp.einsum('nbhts,nbhsv->nbhtv', att, v)
    q_inter = q * jnp.exp(b) * HG_SCALE
    k_state = k * jnp.exp(b_last - b)
    chunk_decay = jnp.exp(b_last[:, :, :, 0])

    def step(state, inp):
        qc, kc, vc, dc = inp
        o = jnp.einsum('bhtd,bhdv->bhtv', qc, state)
        state = state * dc[..., None] + jnp.einsum('bhsd,bhsv->bhdv', kc, vc)
        return state, o

    s0 = jnp.zeros((bsz, h, dk, dv), dtype=q.dtype)
    _, o_inter = lax.scan(step, s0, (q_inter, k_state, v, chunk_decay))
    o = o_intra + o_inter
    return o.transpose(1, 0, 3, 2, 4).reshape(bsz, s, h, dv)


def setup_inputs(seed: int = 0) -> dict:
    key = jax.random.key(seed)
    ks = jax.random.split(key, 20)
    f32 = jnp.float32
    nrm = lambda k, shape, scale: jax.random.normal(k, shape, f32) * scale
    x = jax.random.normal(ks[0], (BATCH, SEQ, D_MODEL), f32)
    w_in = nrm(ks[1], (DEPTH, D_MODEL, IN_COLS), D_MODEL ** -0.5)
    b_merge = nrm(ks[2], (DEPTH, N_BRANCH * D_MODEL), 0.01)
    conv_w = nrm(ks[3], (DEPTH, CONV_WIDTH, LRU_WIDTH), CONV_WIDTH ** -0.5)
    conv_b = nrm(ks[4], (DEPTH, LRU_WIDTH), 0.01)
    rg_wx = nrm(ks[5], (DEPTH, LRU_BLOCKS, LRU_BLOCK_DIM, LRU_BLOCK_DIM), LRU_BLOCK_DIM ** -0.5)
    rg_bx = nrm(ks[6], (DEPTH, LRU_BLOCKS, LRU_BLOCK_DIM), 0.01)
    rg_wa = nrm(ks[7], (DEPTH, LRU_BLOCKS, LRU_BLOCK_DIM, LRU_BLOCK_DIM), LRU_BLOCK_DIM ** -0.5)
    rg_ba = nrm(ks[8], (DEPTH, LRU_BLOCKS, LRU_BLOCK_DIM), 0.01)
    u = jax.random.uniform(ks[9], (DEPTH, LRU_WIDTH), f32, minval=0.9, maxval=0.999)
    a0 = u ** (1.0 / LRU_C)
    rg_lambda = jnp.log(a0) - jnp.log1p(-a0)
    hg_lb_logits = nrm(ks[10], (DEPTH + 1, HG_WIDTH), 0.1)
    hg_norm_g = 1.0 + nrm(ks[11], (DEPTH, HG_HEAD_V), 0.05)
    proj_a = nrm(ks[12], (DEPTH, LRU_WIDTH, D_MODEL), LRU_WIDTH ** -0.5)
    proj_b = nrm(ks[13], (DEPTH, HG_WIDTH, D_MODEL), HG_WIDTH ** -0.5)
    w_out = nrm(ks[14], (DEPTH, D_MODEL, D_MODEL), D_MODEL ** -0.5)
    norm_g = 1.0 + nrm(ks[15], (DEPTH, D_MODEL), 0.05)
    final_norm_g = 1.0 + nrm(ks[16], (D_MODEL,), 0.05)
    return {"x": x, "w_in": w_in, "b_merge": b_merge, "conv_w": conv_w, "conv_b": conv_b,
            "rg_wx": rg_wx, "rg_bx": rg_bx, "rg_wa": rg_wa, "rg_ba": rg_ba, "rg_lambda": rg_lambda,
            "hg_lb_logits": hg_lb_logits, "hg_norm_g": hg_norm_g, "proj_a": proj_a, "proj_b": proj_b,
            "w_out": w_out, "norm_g": norm_g, "final_norm_g": final_norm_g}


def reference(x, w_in, b_merge, conv_w, conv_b, rg_wx, rg_bx, rg_wa, rg_ba, rg_lambda,
              hg_lb_logits, hg_norm_g, proj_a, proj_b, w_out, norm_g, final_norm_g):
    bsz, s, _ = x.shape
    lb_all = jnp.cumsum(jax.nn.softmax(hg_lb_logits.astype(jnp.float32), axis=0), axis=0)
    for l in range(DEPTH):
        h = rms_norm(x, norm_g[l])
        z = h @ w_in[l]
        xa, ga, q, f_pre, i_in, gb, gm = jnp.split(z, SPLITS, axis=-1)

        xa = causal_depthwise_conv(xa, conv_w[l], conv_b[l])
        ya = rg_lru(xa, rg_wx[l], rg_bx[l], rg_wa[l], rg_ba[l], rg_lambda[l])
        ya = ya * jax.nn.silu(ga)
        out_a = ya @ proj_a[l]

        lb = lb_all[l]
        f = lb + (1.0 - lb) * jax.nn.sigmoid(f_pre.astype(jnp.float32))
        log_f = jnp.log(f)
        k = 1.0 - f
        qh = jax.nn.silu(q.astype(jnp.float32))
        heads = lambda t: t.reshape(bsz, s, HG_HEADS, t.shape[-1] // HG_HEADS)
        o = hgrn2_chunked(heads(qh), heads(k), heads(i_in.astype(jnp.float32)), heads(log_f))
        o = rms_norm(o, hg_norm_g[l]).reshape(bsz, s, HG_WIDTH).astype(x.dtype)
        yb = o * jax.nn.silu(gb)
        out_b = yb @ proj_b[l]

        gates = jax.nn.sigmoid(gm + b_merge[l])
        g_a, g_b = jnp.split(gates, N_BRANCH, axis=-1)
        mixed = g_a * out_a + g_b * out_b
        x = x + mixed @ w_out[l]
    return rms_norm(x, final_norm_g)
```

```cpp
#include <hip/hip_runtime.h>
#include <hip/hip_cooperative_groups.h>
#include <cstdio>
#include <cstdint>
namespace cg = cooperative_groups;

#ifndef GATE_SIG_IN_S1
#define GATE_SIG_IN_S1 0
#endif
#ifndef S1_SILU
#define S1_SILU 0
#endif
namespace pg8 {
#define PG8_LAS __attribute__((address_space(3)))
typedef unsigned short bf16_t;
typedef short bf16x8 __attribute__((ext_vector_type(8)));
typedef float f32x4 __attribute__((ext_vector_type(4)));
typedef unsigned u32x4 __attribute__((ext_vector_type(4)));
typedef unsigned u32x2 __attribute__((ext_vector_type(2)));
constexpr int BM = 256, BK = 64, HALF = 128, HTB = HALF * BK * 2  , STAGE_BYTES = 8 * HTB, NXCD = 8, WGM = 8;

__host__ __device__ __forceinline__ int lds_byte(int r, int c) { const int st = (r >> 4) * 2 + (c >> 5), rr = r & 15, cc = c & 31, ob = rr * 64 + cc * 2; return st * 1024 + (ob ^ (((ob >> 9) & 1) << 5)); }
__host__ __device__ __forceinline__ void stage_rc(int b, int& R, int& C) { const int st = b / 1024, sb = b % 1024, swz = sb ^ (((sb >> 9) & 1) << 5); R = (st >> 1) * 16 + swz / 64; C = (st & 1) * 32 + (swz % 64) / 2; }
__host__ __device__ __forceinline__ int perm32(int rho) { const int n = rho >> 4, i = rho & 15; return 8 * (i >> 2) + 4 * n + (i & 3); }

struct Unit { int pm, pn; };
struct Gemm { const bf16_t* A; const bf16_t* Bt; int M, N, K, lda, apn_shift, apn_bytes; };

struct StaticOrder {
    int nM, nN, nwg, G, c;
    __host__ __device__ void init(int M, int N, int G_, int c_) { nM = M / BM; nN = N / BM; nwg = nM * nN; G = G_; c = c_; }
    __host__ __device__ bool next(int i, Unit& u) const {
        const long L = (long)i * G + c; if (L >= nwg) return false;
        int wgid = (int)L; { const int q = nwg / NXCD, r = nwg % NXCD, xcd = wgid % NXCD, off = wgid / NXCD; wgid = (xcd < r ? xcd * (q + 1) : r * (q + 1) + (xcd - r) * q) + off; }
        const int nig = WGM * nN, gid = wgid / nig, fm = gid * WGM, gsz = (nM - fm) < WGM ? (nM - fm) : WGM;
        u.pm = fm + ((wgid % nig) % gsz); u.pn = (wgid % nig) / gsz; return true;
    }
    __device__ __forceinline__ void a_ready(const Unit&) const {}
    __device__ __forceinline__ void done(const Unit&) const {}
};

typedef float f32x2_t __attribute__((ext_vector_type(2)));
typedef __bf16 bf16x2_t __attribute__((ext_vector_type(2)));
__device__ __forceinline__ unsigned cvt_pk_bf16(float lo, float hi) { const f32x2_t v = {lo, hi}; const bf16x2_t b = __builtin_convertvector(v, bf16x2_t); return __builtin_bit_cast(unsigned, b); }
struct ColOrder {
    int pm, pn0, npn;
    __host__ __device__ bool next(int i, Unit& u) const { if (i >= npn) return false; u.pm = pm; u.pn = pn0 + i; return true; }
    __device__ __forceinline__ void a_ready(const Unit&) const {}
    __device__ __forceinline__ void done(const Unit&) const {}
};
__device__ __forceinline__ float bf_lo(unsigned w) { return __builtin_bit_cast(float, w << 16); }
__device__ __forceinline__ float bf_hi(unsigned w) { return __builtin_bit_cast(float, w & 0xffff0000u); }
__device__ __forceinline__ float fsigmoid(float x) { return __builtin_amdgcn_rcpf(1.0f + __builtin_amdgcn_exp2f(-1.44269504089f * x)); }
__device__ __forceinline__ u32x4 pack8(f32x4 v0, f32x4 v1) { u32x4 w; w.x = cvt_pk_bf16(v0[0], v0[1]); w.y = cvt_pk_bf16(v0[2], v0[3]); w.z = cvt_pk_bf16(v1[0], v1[1]); w.w = cvt_pk_bf16(v1[2], v1[3]); return w; }
__device__ __forceinline__ void unpack8(u32x4 w, f32x4& v0, f32x4& v1) { v0 = (f32x4){bf_lo(w.x), bf_hi(w.x), bf_lo(w.y), bf_hi(w.y)}; v1 = (f32x4){bf_lo(w.z), bf_hi(w.z), bf_lo(w.w), bf_hi(w.w)}; }

template <int ACT> struct EpiBf16 {
    static constexpr bool PERM = true, AFTER_DRAIN = false;
    bf16_t* O; size_t split_stride; bf16_t* O1; const float* bias; bf16_t* O6; bf16_t* O7;
    __device__ __forceinline__ void operator()(const f32x4 (&acc)[2][2][4][2], const Unit& u, int, int, int, int) const {
        int t_ = threadIdx.x; asm volatile("" : "+v"(t_));
        const int wid_ = t_ >> 6, wr = wid_ >> 2, wc = wid_ & 3, fr = t_ & 15, fq = (t_ >> 4) & 3;
        const int row0 = u.pm * BM + wr * 64 + fr; int colt = u.pn * BM; const int t = colt >> 10; colt &= 1023;
        bf16_t* base = (t == 1 && O1) ? O1 : O + (size_t)t * split_stride;
        if (ACT == 2) { if (t == 6) base = O6; if (t == 7) base = O7; }
        const int col0 = colt + wc * 32 + 8 * fq, bcol0 = u.pn * BM + wc * 32 + 8 * fq - (ACT == 2 ? 6144 : 0);
        const bool has_bias = (ACT == 1) || (ACT == 2 && GATE_SIG_IN_S1 && t >= 6);
        f32x4 bv[2][2];
#pragma unroll
        for (int bj = 0; bj < 2; ++bj)
#pragma unroll
            for (int n = 0; n < 2; ++n) bv[bj][n] = has_bias ? *(const f32x4*)(bias + bcol0 + bj * HALF + 4 * n) : (f32x4){0.f, 0.f, 0.f, 0.f};
#pragma unroll
        for (int ai = 0; ai < 2; ++ai)
#pragma unroll
            for (int m = 0; m < 4; ++m) { bf16_t* rowp = base + (size_t)(row0 + ai * HALF + m * 16) * 1024 + col0;
#pragma unroll
                for (int bj = 0; bj < 2; ++bj) { f32x4 v0 = acc[ai][bj][m][0] + bv[bj][0], v1 = acc[ai][bj][m][1] + bv[bj][1];
                    if (ACT == 1) {
#pragma unroll
                        for (int i = 0; i < 4; ++i) { v0[i] = fsigmoid(v0[i]); v1[i] = fsigmoid(v1[i]); } }
                    if (ACT == 2) { if (GATE_SIG_IN_S1 && t >= 6) {
#pragma unroll
                        for (int i = 0; i < 4; ++i) { v0[i] = fsigmoid(v0[i]); v1[i] = fsigmoid(v1[i]); } }
                      if (S1_SILU && (t == 2 || t == 5)) { const float sc = (t == 2) ? 0.08838834764831845f : 1.0f;
#pragma unroll
                        for (int i = 0; i < 4; ++i) { v0[i] = v0[i] * fsigmoid(v0[i]) * sc; v1[i] = v1[i] * fsigmoid(v1[i]) * sc; } } }
                    *(u32x4*)(rowp + bj * HALF) = pack8(v0, v1); } }
    }
};
template <int MODE> struct EpiGate {
    static constexpr bool PERM = true, AFTER_DRAIN = false;
    const bf16_t* G; const bf16_t* T; bf16_t* O; const float* gbias;
    __device__ __forceinline__ void operator()(const f32x4 (&acc)[2][2][4][2], const Unit& u, int, int, int, int) const {
        int t_ = threadIdx.x; asm volatile("" : "+v"(t_));
        const int wid_ = t_ >> 6, wr = wid_ >> 2, wc = wid_ & 3, fr = t_ & 15, fq = (t_ >> 4) & 3;
        const int row0 = u.pm * BM + wr * 64 + fr, col0 = u.pn * BM + wc * 32 + 8 * fq;
        f32x4 gb_[2][2];
#pragma unroll
        for (int bj = 0; bj < 2; ++bj)
#pragma unroll
            for (int n = 0; n < 2; ++n) gb_[bj][n] = GATE_SIG_IN_S1 ? (f32x4){0.f, 0.f, 0.f, 0.f} : *(const f32x4*)(gbias + col0 + bj * HALF + 4 * n);
#pragma unroll
        for (int ai = 0; ai < 2; ++ai)
#pragma unroll
            for (int m = 0; m < 4; ++m) { const size_t ro = (size_t)(row0 + ai * HALF + m * 16) * 1024 + col0;
#pragma unroll
                for (int bj = 0; bj < 2; ++bj) {
                    f32x4 g0, g1; unpack8(*(const u32x4*)(G + ro + bj * HALF), g0, g1);
                    if (!GATE_SIG_IN_S1) {
#pragma unroll
                        for (int i = 0; i < 4; ++i) { g0[i] = fsigmoid(g0[i] + gb_[bj][0][i]); g1[i] = fsigmoid(g1[i] + gb_[bj][1][i]); } }
                    f32x4 v0 = acc[ai][bj][m][0] * g0, v1 = acc[ai][bj][m][1] * g1;
                    if (MODE == 1) { f32x4 t0, t1; unpack8(*(const u32x4*)(T + ro + bj * HALF), t0, t1); v0 = v0 + t0; v1 = v1 + t1; }
                    *(u32x4*)(O + ro + bj * HALF) = pack8(v0, v1); } }
    }
};
struct EpiResid {
    static constexpr bool PERM = true, AFTER_DRAIN = false;
    const float* X; float* O;
    __device__ __forceinline__ void operator()(const f32x4 (&acc)[2][2][4][2], const Unit& u, int, int, int, int) const {
        int t_ = threadIdx.x; asm volatile("" : "+v"(t_));
        const int wid_ = t_ >> 6, wr = wid_ >> 2, wc = wid_ & 3, fr = t_ & 15, fq = (t_ >> 4) & 3;
        const int row0 = u.pm * BM + wr * 64 + fr, col0 = u.pn * BM + wc * 32 + 8 * fq;
#pragma unroll
        for (int ai = 0; ai < 2; ++ai)
#pragma unroll
            for (int m = 0; m < 4; ++m) { const size_t ro = (size_t)(row0 + ai * HALF + m * 16) * 1024 + col0;
#pragma unroll
                for (int bj = 0; bj < 2; ++bj) {
                    const f32x4 x0 = *(const f32x4*)(X + ro + bj * HALF), x1 = *(const f32x4*)(X + ro + bj * HALF + 4);
                    *(f32x4*)(O + ro + bj * HALF) = x0 + acc[ai][bj][m][0]; *(f32x4*)(O + ro + bj * HALF + 4) = x1 + acc[ai][bj][m][1]; } }
    }
};

struct PanelOrder {
    int nwg, G, c;
    __host__ __device__ void init(int M, int G_, int c_) { nwg = (M / BM) * 4; G = G_; c = c_; }
    __host__ __device__ bool next(int i, Unit& u) const { const long L = (long)i * G + c; if (L >= nwg) return false;
        if ((G & 31) != 0) { u.pm = (int)(L >> 2); u.pn = (int)(L & 3); return true; }
        const int x = c & 7, k = c >> 3; u.pn = k & 3; u.pm = i * (G >> 2) + (k >> 2) * 8 + x; return true; }
    __device__ __forceinline__ void a_ready(const Unit&) const {}
    __device__ __forceinline__ void done(const Unit&) const {}
};
struct EpiFinal {
    static constexpr bool PERM = true, AFTER_DRAIN = false;
    const float* X; float* O; const float* gain; float* part; unsigned* cnt; PG8_LAS unsigned char* scr;
    __device__ __forceinline__ void operator()(f32x4 (&acc)[2][2][4][2], const Unit& u, int, int, int, int) const {
        int t_ = threadIdx.x; asm volatile("" : "+v"(t_));
        const int wid_ = t_ >> 6, wr = wid_ >> 2, wc = wid_ & 3, fr = t_ & 15, fq = (t_ >> 4) & 3;
        const int row0 = u.pm * BM + wr * 64 + fr, col0 = u.pn * BM + wc * 32 + 8 * fq;
        PG8_LAS float* ssl = (PG8_LAS float*)scr; PG8_LAS float* rstd_l = (PG8_LAS float*)(scr + 4096);
#pragma unroll
        for (int ai = 0; ai < 2; ++ai)
#pragma unroll
            for (int m = 0; m < 4; ++m) { const size_t ro = (size_t)(row0 + ai * HALF + m * 16) * 1024 + col0; float s = 0.f;
#pragma unroll
                for (int bj = 0; bj < 2; ++bj) {
                    const f32x4 x0 = *(const f32x4*)(X + ro + bj * HALF), x1 = *(const f32x4*)(X + ro + bj * HALF + 4);
                    acc[ai][bj][m][0] = acc[ai][bj][m][0] + x0; acc[ai][bj][m][1] = acc[ai][bj][m][1] + x1;
#pragma unroll
                    for (int n = 0; n < 2; ++n) { const f32x4 v = acc[ai][bj][m][n]; s += (v[0] * v[0] + v[1] * v[1]) + (v[2] * v[2] + v[3] * v[3]); } }
                s += __shfl_xor(s, 16); s += __shfl_xor(s, 32);
                if (fq == 0) ssl[((wr * 4 + wc) * 8 + ai * 4 + m) * 16 + fr] = s; }
        asm volatile("s_waitcnt lgkmcnt(0)" ::: "memory"); __builtin_amdgcn_s_barrier(); asm volatile("" ::: "memory");
        const int rr = t_ & 255, r_ai = rr >> 7, r_wr = (rr >> 6) & 1, r_m = (rr >> 4) & 3, r_fr = rr & 15;
        if (t_ < 256) { float s = 0.f;
#pragma unroll
            for (int c = 0; c < 4; ++c) s += ssl[((r_wr * 4 + c) * 8 + r_ai * 4 + r_m) * 16 + r_fr];
            __hip_atomic_store(part + (size_t)(u.pm * 4 + u.pn) * 256 + rr, s, __ATOMIC_RELAXED, __HIP_MEMORY_SCOPE_AGENT);
            asm volatile("s_waitcnt vmcnt(0)" ::: "memory"); }
        asm volatile("s_waitcnt lgkmcnt(0)" ::: "memory"); __builtin_amdgcn_s_barrier(); asm volatile("" ::: "memory");
        if (t_ == 0) { __hip_atomic_fetch_add(cnt + u.pm, 1u, __ATOMIC_RELAXED, __HIP_MEMORY_SCOPE_AGENT);
            unsigned sp = 0; while (__hip_atomic_load(cnt + u.pm, __ATOMIC_RELAXED, __HIP_MEMORY_SCOPE_AGENT) < 4u && ++sp < (1u << 22)) __builtin_amdgcn_s_sleep(2); }
        asm volatile("s_waitcnt vmcnt(0) lgkmcnt(0)" ::: "memory"); __builtin_amdgcn_s_barrier(); asm volatile("" ::: "memory");
        if (t_ < 256) { float s = 0.f;
#pragma unroll
            for (int c = 0; c < 4; ++c) s += __hip_atomic_load(part + (size_t)(u.pm * 4 + c) * 256 + rr, __ATOMIC_RELAXED, __HIP_MEMORY_SCOPE_AGENT);
            rstd_l[rr] = 1.0f / sqrtf(s * (1.0f / 1024.0f) + 1e-6f); }
        asm volatile("s_waitcnt vmcnt(0) lgkmcnt(0)" ::: "memory"); __builtin_amdgcn_s_barrier(); asm volatile("" ::: "memory");
        f32x4 gv[2][2];
#pragma unroll
        for (int bj = 0; bj < 2; ++bj)
#pragma unroll
            for (int n = 0; n < 2; ++n) gv[bj][n] = *(const f32x4*)(gain + col0 + bj * HALF + 4 * n);
#pragma unroll
        for (int ai = 0; ai < 2; ++ai)
#pragma unroll
            for (int m = 0; m < 4; ++m) { const size_t ro = (size_t)(row0 + ai * HALF + m * 16) * 1024 + col0; const float rs = rstd_l[ai * 128 + wr * 64 + m * 16 + fr];
#pragma unroll
                for (int bj = 0; bj < 2; ++bj) { *(f32x4*)(O + ro + bj * HALF) = (acc[ai][bj][m][0] * rs) * gv[bj][0]; *(f32x4*)(O + ro + bj * HALF + 4) = (acc[ai][bj][m][1] * rs) * gv[bj][1]; } }
        asm volatile("s_waitcnt lgkmcnt(0)" ::: "memory");
    }
};


template <class Epi, class Sched, bool ALIGN_EPI = false, bool SP2 = false>
__device__ __forceinline__ void gemm_phase(PG8_LAS unsigned char* lds, const Gemm g, const Sched& S, const Epi& E) {
    int tid = threadIdx.x; asm volatile("" : "+v"(tid));
    const int wid = __builtin_amdgcn_readfirstlane(tid >> 6), lane = tid & 63, wr = wid >> 2, wc = wid & 3, fr = lane & 15, fq = lane >> 4;
    int K = g.K; asm volatile("" : "+s"(K)); const int nt = K / BK;
    unsigned voffA[2], voffB[2];
#pragma unroll
    for (int i = 0; i < 2; ++i) { int R, C; stage_rc(tid * 16 + i * 8192, R, C); const int Rb = Epi::PERM ? ((R & ~31) + perm32(R & 31)) : R;
        voffA[i] = (unsigned)(R * g.lda + C) * 2u; voffB[i] = (unsigned)(Rb * K + C) * 2u; }
    const size_t kstep = (size_t)(BK * 2);
    const size_t hstepB = (size_t)HALF * K * 2, hstepA = (size_t)HALF * g.lda * 2;
    const size_t tstepB = 2 * hstepB, tstepA = 2 * hstepA;
    const unsigned ldsw = (unsigned)wid * 1024u;
    const int aoff = lds_byte(wr * 64 + fr, fq * 8), boff = lds_byte(wc * 32 + fr, fq * 8);
#define PG8_SA(b, h) (((b) * 2 + (h)) * HTB)
#define PG8_SB(b, h) ((4 + (b) * 2 + (h)) * HTB)
#define PG8_STAGE(bufoff, gbase, voff) do { _Pragma("unroll") for (int _i = 0; _i < 2; ++_i) \
        __builtin_amdgcn_global_load_lds((const unsigned*)((const char*)(gbase) + (voff)[_i]), (PG8_LAS unsigned*)(lds + (bufoff) + ldsw + _i * 8192), 16, 0, 0); } while (0)
#define PG8_LDA(dst, b, h) do { _Pragma("unroll") for (int m = 0; m < 4; ++m) _Pragma("unroll") for (int k = 0; k < 2; ++k) dst[m][k] = *(const PG8_LAS bf16x8*)(lds + PG8_SA(b, h) + aoff + m * 2048 + k * 1024); } while (0)
#define PG8_LDB(dst, b, h) do { _Pragma("unroll") for (int n = 0; n < 2; ++n) _Pragma("unroll") for (int k = 0; k < 2; ++k) dst[n][k] = *(const PG8_LAS bf16x8*)(lds + PG8_SB(b, h) + boff + n * 2048 + k * 1024); } while (0)
#define PG8_MMA(ai, bj, At, Bt) do { __builtin_amdgcn_s_setprio(1); _Pragma("unroll") for (int m = 0; m < 4; ++m) _Pragma("unroll") for (int n = 0; n < 2; ++n) _Pragma("unroll") for (int k = 0; k < 2; ++k) \
        acc[ai][bj][m][n] = __builtin_amdgcn_mfma_f32_16x16x32_bf16(Bt[n][k], At[m][k], acc[ai][bj][m][n], 0, 0, 0); __builtin_amdgcn_s_setprio(0); } while (0)
#define PG8_WAIT_V(n) asm volatile("s_waitcnt vmcnt(" #n ")" ::: "memory")
#define PG8_WAIT_L(n) asm volatile("s_waitcnt lgkmcnt(" #n ")" ::: "memory")
#define PG8_BAR __builtin_amdgcn_s_barrier()
#define PG8_SCHED __builtin_amdgcn_sched_barrier(0)
    Unit cur, nxt; int ui = 0;
    if (!S.next(0, cur)) return;
    f32x4 acc[2][2][4][2];
#pragma unroll
    for (int a = 0; a < 2; ++a)
#pragma unroll
        for (int b = 0; b < 2; ++b)
#pragma unroll
            for (int m = 0; m < 4; ++m)
#pragma unroll
                for (int n = 0; n < 2; ++n) acc[a][b][m][n] = (f32x4){0.f, 0.f, 0.f, 0.f};
    bf16x8 At[4][2], B0[2][2], B1[2][2];
    const char* cA = (const char*)g.A + (size_t)cur.pm * tstepA + (size_t)(cur.pn >> g.apn_shift) * g.apn_bytes; const char* cB = (const char*)g.Bt + (size_t)cur.pn * tstepB;
    S.a_ready(cur);
    if constexpr (SP2) {
        PG8_STAGE(PG8_SB(0, 0), cB, voffB); PG8_STAGE(PG8_SB(0, 1), cB + hstepB, voffB); PG8_STAGE(PG8_SA(0, 0), cA, voffA); PG8_STAGE(PG8_SA(0, 1), cA + hstepA, voffA);
        if (wr == 1) PG8_BAR;
        PG8_WAIT_V(2); PG8_BAR;
        PG8_STAGE(PG8_SB(1, 0), cB + kstep, voffB); PG8_STAGE(PG8_SA(1, 0), cA + kstep, voffA); PG8_STAGE(PG8_SB(1, 1), cB + hstepB + kstep, voffB);
        PG8_WAIT_V(6); PG8_BAR;
    } else {
        PG8_STAGE(PG8_SB(0, 0), cB, voffB); PG8_STAGE(PG8_SA(0, 0), cA, voffA); PG8_STAGE(PG8_SB(0, 1), cB + hstepB, voffB); PG8_STAGE(PG8_SA(0, 1), cA + hstepA, voffA);
        if (wr == 1) PG8_BAR;
        PG8_WAIT_V(4); PG8_BAR;
        PG8_STAGE(PG8_SB(1, 0), cB + kstep, voffB); PG8_STAGE(PG8_SA(1, 0), cA + kstep, voffA); PG8_STAGE(PG8_SB(1, 1), cB + hstepB + kstep, voffB);
        PG8_WAIT_V(6); PG8_BAR;
    }
    for (;;) {
        const bool has_next = S.next(ui + 1, nxt);
        const char* nA = has_next ? (const char*)g.A + (size_t)nxt.pm * tstepA + (size_t)(nxt.pn >> g.apn_shift) * g.apn_bytes : cA; const char* nB = has_next ? (const char*)g.Bt + (size_t)nxt.pn * tstepB : cB;
        for (int t = 0; t < nt; t += 2) {
            const bool last = (t == nt - 2);
            const char* a1 = cA + (size_t)(t + 1) * kstep;
            const char* a2 = last ? nA : cA + (size_t)(t + 2) * kstep; const char* b2 = last ? nB : cB + (size_t)(t + 2) * kstep;
            const char* a3 = a2 + kstep; const char* b3 = b2 + kstep;
            if (last && has_next) S.a_ready(nxt);
            if constexpr (SP2) {
            PG8_LDB(B0, 0, 0); PG8_LDB(B1, 0, 1); PG8_SCHED; PG8_LDA(At, 0, 0); PG8_STAGE(PG8_SA(1, 1), a1 + hstepA, voffA);
            PG8_WAIT_V(8); PG8_WAIT_L(0); PG8_BAR; PG8_MMA(0, 0, At, B0); PG8_MMA(0, 1, At, B1); PG8_BAR; PG8_SCHED;
            PG8_LDA(At, 0, 1); PG8_STAGE(PG8_SB(0, 0), b2, voffB); PG8_STAGE(PG8_SB(0, 1), b2 + hstepB, voffB); PG8_STAGE(PG8_SA(0, 0), a2, voffA);
            PG8_WAIT_V(8); PG8_WAIT_L(0); PG8_BAR; PG8_MMA(1, 0, At, B0); PG8_MMA(1, 1, At, B1); PG8_BAR; PG8_SCHED;
            PG8_LDB(B0, 1, 0); PG8_LDB(B1, 1, 1); PG8_SCHED; PG8_LDA(At, 1, 0); PG8_STAGE(PG8_SA(0, 1), a2 + hstepA, voffA);
            PG8_WAIT_V(8); PG8_WAIT_L(0); PG8_BAR; PG8_MMA(0, 0, At, B0); PG8_MMA(0, 1, At, B1); PG8_BAR; PG8_SCHED;
            PG8_LDA(At, 1, 1); PG8_STAGE(PG8_SB(1, 0), b3, voffB); PG8_STAGE(PG8_SB(1, 1), b3 + hstepB, voffB); PG8_STAGE(PG8_SA(1, 0), a3, voffA);
            PG8_WAIT_V(8); PG8_WAIT_L(0); PG8_BAR; PG8_MMA(1, 0, At, B0); PG8_MMA(1, 1, At, B1); PG8_BAR; PG8_SCHED;
            } else {
            PG8_LDB(B0, 0, 0); PG8_SCHED; PG8_LDA(At, 0, 0); PG8_STAGE(PG8_SA(1, 1), a1 + hstepA, voffA);
            PG8_WAIT_L(8); PG8_BAR; PG8_WAIT_L(0); PG8_MMA(0, 0, At, B0); PG8_BAR; PG8_SCHED;
            PG8_LDB(B1, 0, 1); PG8_STAGE(PG8_SB(0, 0), b2, voffB);
            PG8_BAR; PG8_WAIT_L(0); PG8_MMA(0, 1, At, B1); PG8_BAR;
            PG8_LDA(At, 0, 1); PG8_STAGE(PG8_SA(0, 0), a2, voffA);
            PG8_BAR; PG8_WAIT_L(0); PG8_MMA(1, 0, At, B0); PG8_BAR; PG8_SCHED;
            PG8_STAGE(PG8_SB(0, 1), b2 + hstepB, voffB);
            PG8_WAIT_V(6); PG8_BAR; PG8_MMA(1, 1, At, B1); PG8_BAR;
            PG8_LDB(B0, 1, 0); PG8_SCHED; PG8_LDA(At, 1, 0); PG8_STAGE(PG8_SA(0, 1), a2 + hstepA, voffA);
            PG8_WAIT_L(8); PG8_BAR; PG8_WAIT_L(0); PG8_MMA(0, 0, At, B0); PG8_BAR; PG8_SCHED;
            PG8_LDB(B1, 1, 1); PG8_STAGE(PG8_SB(1, 0), b3, voffB);
            PG8_BAR; PG8_WAIT_L(0); PG8_MMA(0, 1, At, B1); PG8_BAR;
            PG8_LDA(At, 1, 1); PG8_STAGE(PG8_SA(1, 0), a3, voffA);
            PG8_BAR; PG8_WAIT_L(0); PG8_MMA(1, 0, At, B0); PG8_BAR; PG8_SCHED;
            PG8_STAGE(PG8_SB(1, 1), b3 + hstepB, voffB);
            PG8_WAIT_V(6); PG8_BAR; PG8_MMA(1, 1, At, B1); PG8_BAR;
            }
        }
        if constexpr (ALIGN_EPI) { if (wr == 0) PG8_BAR; }
        if constexpr (!Epi::AFTER_DRAIN) { E(acc, cur, wr, wc, fr, fq); S.done(cur); }
        if (!has_next) break;
#pragma unroll
        for (int a = 0; a < 2; ++a)
#pragma unroll
            for (int b = 0; b < 2; ++b)
#pragma unroll
                for (int m = 0; m < 4; ++m)
#pragma unroll
                    for (int n = 0; n < 2; ++n) acc[a][b][m][n] = (f32x4){0.f, 0.f, 0.f, 0.f};
        cur = nxt; cA = nA; cB = nB; ++ui;
        if constexpr (ALIGN_EPI) { if (wr == 1) PG8_BAR; }
    }
    PG8_WAIT_V(0);
    if constexpr (!ALIGN_EPI) { if (wr == 0) PG8_BAR; }
    PG8_BAR;
    if constexpr (Epi::AFTER_DRAIN) { E.fused(acc, cur, wr, wc, fr, fq, lds, wid, lane); S.done(cur); }
#undef PG8_SA
#undef PG8_SB
#undef PG8_STAGE
#undef PG8_LDA
#undef PG8_LDB
#undef PG8_MMA
#undef PG8_WAIT_V
#undef PG8_WAIT_L
#undef PG8_BAR
#undef PG8_SCHED
}
}

#define LAS __attribute__((address_space(3)))
typedef unsigned short bf16;
typedef pg8::f32x4 f32x4;
typedef pg8::u32x4 u32x4;
typedef pg8::u32x2 u32x2;
typedef float f32x2 __attribute__((ext_vector_type(2)));
typedef pg8::bf16x8 bf16x8;
using pg8::cvt_pk_bf16; using pg8::bf_lo; using pg8::bf_hi; using pg8::fsigmoid;

constexpr int M = 32768, D = 1024, SEQ = 2048, NB = 16, NHEAD = 8;
constexpr int ZCOLS = 6144;
constexpr size_t SLOT = (size_t)M * D * 2;
constexpr size_t WS_H = 0 * SLOT, WS_XA = 1 * SLOT, WS_GA = 2 * SLOT, WS_Q = 3 * SLOT, WS_F = 4 * SLOT, WS_I = 5 * SLOT, WS_GB = 6 * SLOT, WS_MISC = 7 * SLOT;
constexpr size_t MS_WIN = 0, MS_PA = (size_t)16 << 20, MS_PB = (size_t)18 << 20, MS_WO = (size_t)20 << 20, MS_GBT = (size_t)22 << 20, MS_SP8 = (size_t)23 << 20, MS_BAR = ((size_t)23 << 20) + 4096, MS_CNT = MS_BAR + 14336, MS_PART = (size_t)24 << 20, MS_END = ((size_t)24 << 20) + ((size_t)1 << 20);
constexpr size_t WS_NEED = WS_MISC + MS_END;
constexpr int LDS_BYTES = 144 * 1024;
constexpr float EPS = 1e-6f;
constexpr float L2E = 1.44269504089f;

__device__ __forceinline__ float wave_sum(float v) {
#pragma unroll
    for (int o = 1; o < 64; o <<= 1) v += __shfl_xor(v, o);
    return v;
}
__device__ __forceinline__ float fsilu(float x) { return x * fsigmoid(x); }

__device__ __forceinline__ void p0_transpose_item(const float* W, int K, int N, bf16* WT, LAS float* scr, int item, int lane) {
    const int nblk = N / 32, kb = item / nblk, nb = item % nblk, k0 = 64 * kb, n0 = 32 * nb;
#pragma unroll 8
    for (int i = 0; i < 32; ++i) { const int kk = 2 * i + (lane >> 5); scr[kk * 33 + (lane & 31)] = W[(size_t)(k0 + kk) * N + n0 + (lane & 31)]; }
    asm volatile("s_waitcnt lgkmcnt(0)" ::: "memory");
    const int c = lane & 7;
#pragma unroll
    for (int j = 0; j < 4; ++j) { const int n = (lane >> 3) + 8 * j; const LAS float* s = scr + (8 * c) * 33 + n;
        u32x4 o; o.x = cvt_pk_bf16(s[0 * 33], s[1 * 33]); o.y = cvt_pk_bf16(s[2 * 33], s[3 * 33]); o.z = cvt_pk_bf16(s[4 * 33], s[5 * 33]); o.w = cvt_pk_bf16(s[6 * 33], s[7 * 33]);
        *(u32x4*)(WT + (size_t)(n0 + n) * K + k0 + 8 * c) = o; }
    asm volatile("s_waitcnt lgkmcnt(0)" ::: "memory");
}
template <int NR> __device__ __forceinline__ void rms_rows_to_bf16(const float* X, const float* g, bf16* O, int m0, int stride, int lane) {
    f32x4 v[NR][4]; float s[NR];
#pragma unroll
    for (int r = 0; r < NR; ++r) { const f32x4* xr = (const f32x4*)(X + (size_t)(m0 + r * stride) * D) + lane;
#pragma unroll
        for (int j = 0; j < 4; ++j) v[r][j] = xr[64 * j]; }
    f32x4 gg[4];
#pragma unroll
    for (int j = 0; j < 4; ++j) gg[j] = ((const f32x4*)g + lane)[64 * j];
#pragma unroll
    for (int r = 0; r < NR; ++r) { float a = 0.f;
#pragma unroll
        for (int j = 0; j < 4; ++j) a += (v[r][j].x * v[r][j].x + v[r][j].y * v[r][j].y) + (v[r][j].z * v[r][j].z + v[r][j].w * v[r][j].w);
        s[r] = a; }
#pragma unroll
    for (int o = 1; o < 64; o <<= 1) {
#pragma unroll
        for (int r = 0; r < NR; ++r) s[r] += __shfl_xor(s[r], o); }
#pragma unroll
    for (int r = 0; r < NR; ++r) { const float rstd = 1.0f / sqrtf(s[r] * (1.f / D) + EPS); u32x2* o8 = (u32x2*)(O + (size_t)(m0 + r * stride) * D) + lane;
#pragma unroll
        for (int j = 0; j < 4; ++j) { u32x2 o; o.x = cvt_pk_bf16(v[r][j].x * rstd * gg[j].x, v[r][j].y * rstd * gg[j].y); o.y = cvt_pk_bf16(v[r][j].z * rstd * gg[j].z, v[r][j].w * rstd * gg[j].w); o8[64 * j] = o; } }
}
template <int NR> __device__ __forceinline__ void rms_rows_inplace(float* X, const float* g, int m0, int stride, int lane) {
    f32x4 v[NR][4]; float s[NR];
#pragma unroll
    for (int r = 0; r < NR; ++r) { const f32x4* xr = (const f32x4*)(X + (size_t)(m0 + r * stride) * D) + lane;
#pragma unroll
        for (int j = 0; j < 4; ++j) v[r][j] = xr[64 * j]; }
    f32x4 gg[4];
#pragma unroll
    for (int j = 0; j < 4; ++j) gg[j] = ((const f32x4*)g + lane)[64 * j];
#pragma unroll
    for (int r = 0; r < NR; ++r) { float a = 0.f;
#pragma unroll
        for (int j = 0; j < 4; ++j) a += (v[r][j].x * v[r][j].x + v[r][j].y * v[r][j].y) + (v[r][j].z * v[r][j].z + v[r][j].w * v[r][j].w);
        s[r] = a; }
#pragma unroll
    for (int o = 1; o < 64; o <<= 1) {
#pragma unroll
        for (int r = 0; r < NR; ++r) s[r] += __shfl_xor(s[r], o); }
#pragma unroll
    for (int r = 0; r < NR; ++r) { const float rstd = 1.0f / sqrtf(s[r] * (1.f / D) + EPS); f32x4* xr = (f32x4*)(X + (size_t)(m0 + r * stride) * D) + lane;
#pragma unroll
        for (int j = 0; j < 4; ++j) xr[64 * j] = (v[r][j] * rstd) * gg[j]; }
}

struct Params {
    const float *x, *w_in, *b_merge, *conv_w, *conv_b, *rg_wx, *rg_bx, *rg_wa, *rg_ba, *rg_lambda, *hg_lb, *hg_norm_g, *proj_a, *proj_b, *w_out, *norm_g, *final_g;
    float* out; unsigned char* ws; unsigned* bar; int use_cg_sync; int pad;
};

__device__ __forceinline__ void p0_prologue(const Params& P, LAS unsigned char* lds, int wave, int lane) {
    unsigned char* ms = P.ws + WS_MISC;
    LAS float* scr = (LAS float*)(lds + wave * 16384);
    const int G = gridDim.x, gw = blockIdx.x * 8 + wave, NGW = G * 8;
    constexpr int I_IN = (D / 64) * (8192 / 32), I_P = (D / 64) * (D / 32);
    for (int it = gw; it < I_IN + 3 * I_P; it += NGW) {
        int r = it;
        if (r < I_IN) { p0_transpose_item(P.w_in, D, 8192, (bf16*)(ms + MS_WIN), scr, r, lane); continue; } r -= I_IN;
        if (r < I_P) { p0_transpose_item(P.proj_a, D, D, (bf16*)(ms + MS_PA), scr, r, lane); continue; } r -= I_P;
        if (r < I_P) { p0_transpose_item(P.proj_b, D, D, (bf16*)(ms + MS_PB), scr, r, lane); continue; } r -= I_P;
        p0_transpose_item(P.w_out, D, D, (bf16*)(ms + MS_WO), scr, r, lane);
    }
    { bf16* GB = (bf16*)(ms + MS_GBT); const int gt = blockIdx.x * 512 + wave * 64 + lane, GT = G * 512;
      for (int e = gt; e < 2048 * 256; e += GT) { const int cl = e & 127, k = (e >> 7) & 255, gate = (e >> 15) & 1, blk = e >> 16;
          const int kin = k - 128 * (blk & 1); float v = 0.f;
          if (kin >= 0 && kin < 128) v = (gate ? P.rg_wa : P.rg_wx)[((size_t)blk * 128 + kin) * 128 + cl];
          GB[(size_t)(256 * blk + 128 * gate + cl) * 256 + k] = (bf16)(cvt_pk_bf16(v, 0.f) & 0xffffu); }
      float* sp8 = (float*)(ms + MS_SP8);
      for (int e = gt; e < D; e += GT) sp8[e] = 8.0f * log1pf(expf(-P.rg_lambda[e])); }
    bf16* H = (bf16*)(P.ws + WS_H);
    for (int m = gw; m < M; m += 4 * NGW) rms_rows_to_bf16<4>(P.x, P.norm_g, H, m, NGW, lane);
}

constexpr int HG_QIN = 0, HG_KIN = 17408, HG_QINT = 34816, HG_KST = 52224, HG_VT = 70656, HG_ATT = 89088, HG_ST = 98304, HG_TOT = 133120, HG_LF = 137216, HG_DEC = 137728, HG_SSQ = 138240;
__device__ __forceinline__ bf16x8 lds_frag(LAS unsigned char* p) { return *(const LAS bf16x8*)p; }

#define HG_PREP1(NXT_ROW)                                                                                                   \
    _Pragma("unroll") for (int tt = 0; tt < 8; ++tt) { _Pragma("unroll") for (int c = 0; c < 2; ++c) {                     \
        const float fp = c ? bf_hi(rf[tt]) : bf_lo(rf[tt]);                                                                 \
        { const float qv_ = c ? bf_hi(rq[tt]) : bf_lo(rq[tt]); qh[tt][c] = S1_SILU ? qv_ : fsilu(qv_) * 0.08838834764831845f; } vv[tt][c] = c ? bf_hi(ri[tt]) : bf_lo(ri[tt]); \
        const float sg = fsigmoid(fp), f = lb[c] + (1.0f - lb[c]) * sg;                                                     \
        kk[tt][c] = (1.0f - lb[c]) * (1.0f - sg); pf[tt][c] = tt ? f * pf[tt - 1][c] : f; } }                               \
    *(LAS f32x2*)(lds + HG_TOT + (w * 128 + d0) * 4) = (f32x2){pf[7][0], pf[7][1]};                                         \
    if (w == 4) *(LAS f32x2*)(lds + HG_LF + d0 * 4) = (f32x2){pf[0][0], pf[0][1]};                                          \
    { const size_t nr_ = ((NXT_ROW) < row0 + SEQ) ? (NXT_ROW) : row0 + SEQ - 64;     \
      _Pragma("unroll") for (int tt = 0; tt < 8; ++tt) { const size_t o = (nr_ + w * 8 + tt) * D + colq; \
        rq[tt] = *(const unsigned*)(Qs + o); rf[tt] = *(const unsigned*)(Fs + o); ri[tt] = *(const unsigned*)(Is + o); } }
__device__ __forceinline__ void hgrn_item2(const Params& P, LAS unsigned char* lds, int b, int hd, int w, int l, bf16* YB) {
    const bf16* Qs = (const bf16*)(P.ws + WS_Q); const bf16* Fs = (const bf16*)(P.ws + WS_F); const bf16* Is = (const bf16*)(P.ws + WS_I); const bf16* GBs = (const bf16*)(P.ws + WS_GB);
    const int fr = l & 15, fq = l >> 4, ti = w >> 1, wh = w & 1, th = w >> 2, vq = w & 3;
    const int d0 = 2 * l;
    float lb[2];
#pragma unroll
    for (int c = 0; c < 2; ++c) { const float l0 = P.hg_lb[hd * 128 + d0 + c], l1 = P.hg_lb[D + hd * 128 + d0 + c]; lb[c] = 1.0f / (1.0f + expf(l1 - l0)); }
    f32x4 gn[2];
#pragma unroll
    for (int vv2 = 0; vv2 < 2; ++vv2) gn[vv2] = *(const f32x4*)(P.hg_norm_g + 16 * (2 * vq + vv2) + 4 * fq);
    f32x4 S[4][2];
#pragma unroll
    for (int i = 0; i < 4; ++i) { S[i][0] = (f32x4){0.f, 0.f, 0.f, 0.f}; S[i][1] = S[i][0]; }
    __syncthreads();
    for (int e = w * 64 + l; e < 34816 / 4; e += 512) ((LAS unsigned*)(lds + HG_ST))[e] = 0u;
    const size_t row0 = (size_t)b * SEQ;
    const int colq = hd * 128 + d0;
    unsigned rq[8], rf[8], ri[8];
#pragma unroll
    for (int tt = 0; tt < 8; ++tt) { const size_t o = (row0 + w * 8 + tt) * D + colq; rq[tt] = *(const unsigned*)(Qs + o); rf[tt] = *(const unsigned*)(Fs + o); ri[tt] = *(const unsigned*)(Is + o); }
    float qh[8][2], kk[8][2], pf[8][2], vv[8][2];
    HG_PREP1(row0 + 64)
    __syncthreads();
    for (int n = 0; n < 32; ++n) {
        const size_t crow = row0 + (size_t)n * 64;
        u32x2 gbv[2][2];
#pragma unroll
        for (int tt2 = 0; tt2 < 2; ++tt2)
#pragma unroll
            for (int vv2 = 0; vv2 < 2; ++vv2) gbv[tt2][vv2] = *(const u32x2*)(GBs + (crow + 16 * (2 * th + tt2) + fr) * D + hd * 128 + 16 * (2 * vq + vv2) + 4 * fq);
        { float off[2] = {1.f, 1.f}, pmid[2] = {1.f, 1.f}, plast[2] = {1.f, 1.f};
#pragma unroll
          for (int g = 0; g < 8; ++g) { const f32x2 t2 = *(const LAS f32x2*)(lds + HG_TOT + (g * 128 + d0) * 4);
              if (g < w) { off[0] *= t2.x; off[1] *= t2.y; }
              if (g < 4) { pmid[0] *= t2.x; pmid[1] *= t2.y; }
              plast[0] *= t2.x; plast[1] *= t2.y; }
          { const f32x2 t2 = *(const LAS f32x2*)(lds + HG_LF + d0 * 4); pmid[0] *= t2.x; pmid[1] *= t2.y; }
          float rpmid[2];
#pragma unroll
          for (int c = 0; c < 2; ++c) rpmid[c] = __builtin_amdgcn_rcpf(pmid[c]);
          if (w == 0) *(LAS f32x2*)(lds + HG_DEC + d0 * 4) = (f32x2){plast[0], plast[1]};
          float kst[8][2];
#pragma unroll
          for (int tt = 0; tt < 8; ++tt) {
              float qin[2], kin[2], qint[2];
#pragma unroll
              for (int c = 0; c < 2; ++c) {
                  const float Pt = off[c] * pf[tt][c], rP = __builtin_amdgcn_rcpf(Pt);
                  qint[c] = qh[tt][c] * Pt; qin[c] = qint[c] * rpmid[c];
                  const float kr = kk[tt][c] * rP; kin[c] = kr * pmid[c]; kst[tt][c] = kr * plast[c];
              }
              const int t = w * 8 + tt;
              *(LAS unsigned*)(lds + HG_QIN + t * 272 + d0 * 2) = cvt_pk_bf16(qin[0], qin[1]);
              *(LAS unsigned*)(lds + HG_KIN + t * 272 + d0 * 2) = cvt_pk_bf16(kin[0], kin[1]);
              *(LAS unsigned*)(lds + HG_QINT + t * 272 + d0 * 2) = cvt_pk_bf16(qint[0], qint[1]);
          }
#pragma unroll
          for (int c = 0; c < 2; ++c) {
              u32x4 pk, pv;
              pk.x = cvt_pk_bf16(kst[0][c], kst[1][c]); pk.y = cvt_pk_bf16(kst[2][c], kst[3][c]); pk.z = cvt_pk_bf16(kst[4][c], kst[5][c]); pk.w = cvt_pk_bf16(kst[6][c], kst[7][c]);
              pv.x = cvt_pk_bf16(vv[0][c], vv[1][c]); pv.y = cvt_pk_bf16(vv[2][c], vv[3][c]); pv.z = cvt_pk_bf16(vv[4][c], vv[5][c]); pv.w = cvt_pk_bf16(vv[6][c], vv[7][c]);
              *(LAS u32x4*)(lds + HG_KST + (d0 + c) * 144 + w * 16) = pk;
              *(LAS u32x4*)(lds + HG_VT + (d0 + c) * 144 + w * 16) = pv;
          } }
        __syncthreads();
        HG_PREP1(crow + 128)
        { bf16x8 yq[4];
#pragma unroll
          for (int ks = 0; ks < 4; ++ks) yq[ks] = lds_frag(lds + HG_QIN + (16 * ti + fr) * 272 + ks * 64 + fq * 16);
#pragma unroll
          for (int sjj = 0; sjj < 2; ++sjj) { const int sj = wh * 2 + sjj;
              f32x4 a = (f32x4){0.f, 0.f, 0.f, 0.f};
#pragma unroll
              for (int ks = 0; ks < 4; ++ks) a = __builtin_amdgcn_mfma_f32_16x16x32_bf16(lds_frag(lds + HG_KIN + (16 * sj + fr) * 272 + ks * 64 + fq * 16), yq[ks], a, 0, 0, 0);
              const int t = 16 * ti + fr, s0 = 16 * sj + 4 * fq;
#pragma unroll
              for (int j = 0; j < 4; ++j) a[j] = (s0 + j <= t) ? a[j] : 0.f;
              u32x2 pk; pk.x = cvt_pk_bf16(a[0], a[1]); pk.y = cvt_pk_bf16(a[2], a[3]);
              *(LAS u32x2*)(lds + HG_ATT + (16 * ti + fr) * 144 + (16 * sj + 4 * fq) * 2) = pk; } }
        f32x4 oa[2][2];
#pragma unroll
        for (int i = 0; i < 2; ++i) { oa[i][0] = (f32x4){0.f, 0.f, 0.f, 0.f}; oa[i][1] = oa[i][0]; }
#pragma unroll
        for (int ks = 0; ks < 4; ++ks) {
            bf16x8 yf[2], xf[2];
#pragma unroll
            for (int i = 0; i < 2; ++i) { yf[i] = lds_frag(lds + HG_QINT + (16 * (2 * th + i) + fr) * 272 + ks * 64 + fq * 16); xf[i] = lds_frag(lds + HG_ST + (16 * (2 * vq + i) + fr) * 272 + ks * 64 + fq * 16); }
#pragma unroll
            for (int tt2 = 0; tt2 < 2; ++tt2)
#pragma unroll
                for (int vv2 = 0; vv2 < 2; ++vv2) oa[tt2][vv2] = __builtin_amdgcn_mfma_f32_16x16x32_bf16(xf[vv2], yf[tt2], oa[tt2][vv2], 0, 0, 0);
        }
        __syncthreads();
#pragma unroll
        for (int ks = 0; ks < 2; ++ks) {
            bf16x8 yf[2], xf[2];
#pragma unroll
            for (int i = 0; i < 2; ++i) { yf[i] = lds_frag(lds + HG_ATT + (16 * (2 * th + i) + fr) * 144 + ks * 64 + fq * 16); xf[i] = lds_frag(lds + HG_VT + (16 * (2 * vq + i) + fr) * 144 + ks * 64 + fq * 16); }
#pragma unroll
            for (int tt2 = 0; tt2 < 2; ++tt2)
#pragma unroll
                for (int vv2 = 0; vv2 < 2; ++vv2) oa[tt2][vv2] = __builtin_amdgcn_mfma_f32_16x16x32_bf16(xf[vv2], yf[tt2], oa[tt2][vv2], 0, 0, 0);
        }
#pragma unroll
        for (int tt2 = 0; tt2 < 2; ++tt2) { float ss = 0.f;
#pragma unroll
            for (int vv2 = 0; vv2 < 2; ++vv2) ss += (oa[tt2][vv2][0] * oa[tt2][vv2][0] + oa[tt2][vv2][1] * oa[tt2][vv2][1]) + (oa[tt2][vv2][2] * oa[tt2][vv2][2] + oa[tt2][vv2][3] * oa[tt2][vv2][3]);
            ss += __shfl_xor(ss, 16); ss += __shfl_xor(ss, 32);
            if (fq == 0) *(LAS float*)(lds + HG_SSQ + (vq * 64 + 16 * (2 * th + tt2) + fr) * 4) = ss; }
#pragma unroll
        for (int dd = 0; dd < 4; ++dd) { const f32x4 dec = *(const LAS f32x4*)(lds + HG_DEC + (16 * (4 * th + dd) + 4 * fq) * 4);
            S[dd][0] = S[dd][0] * dec; S[dd][1] = S[dd][1] * dec; }
#pragma unroll
        for (int ks = 0; ks < 2; ++ks) {
            bf16x8 yv[2];
#pragma unroll
            for (int i = 0; i < 2; ++i) yv[i] = lds_frag(lds + HG_VT + (16 * (2 * vq + i) + fr) * 144 + ks * 64 + fq * 16);
#pragma unroll
            for (int dd = 0; dd < 4; ++dd) { const bf16x8 xk = lds_frag(lds + HG_KST + (16 * (4 * th + dd) + fr) * 144 + ks * 64 + fq * 16);
                S[dd][0] = __builtin_amdgcn_mfma_f32_16x16x32_bf16(xk, yv[0], S[dd][0], 0, 0, 0);
                S[dd][1] = __builtin_amdgcn_mfma_f32_16x16x32_bf16(xk, yv[1], S[dd][1], 0, 0, 0); }
        }
#pragma unroll
        for (int dd = 0; dd < 4; ++dd)
#pragma unroll
            for (int vv2 = 0; vv2 < 2; ++vv2) { const f32x4 sv = S[dd][vv2]; u32x2 pk; pk.x = cvt_pk_bf16(sv[0], sv[1]); pk.y = cvt_pk_bf16(sv[2], sv[3]);
                *(LAS u32x2*)(lds + HG_ST + (16 * (2 * vq + vv2) + fr) * 272 + (16 * (4 * th + dd) + 4 * fq) * 2) = pk; }
        __syncthreads();
#pragma unroll
        for (int tt2 = 0; tt2 < 2; ++tt2) { const int t = 16 * (2 * th + tt2) + fr;
            const float tot = (*(const LAS float*)(lds + HG_SSQ + t * 4) + *(const LAS float*)(lds + HG_SSQ + (64 + t) * 4)) + (*(const LAS float*)(lds + HG_SSQ + (128 + t) * 4) + *(const LAS float*)(lds + HG_SSQ + (192 + t) * 4));
            const float rstd = 1.0f / sqrtf(tot * (1.f / 128.f) + EPS);
#pragma unroll
            for (int vv2 = 0; vv2 < 2; ++vv2) {
                const size_t o = (crow + t) * D + hd * 128 + 16 * (2 * vq + vv2) + 4 * fq;
                const u32x2 g2 = gbv[tt2][vv2]; const f32x4 ov = oa[tt2][vv2];
                float g0 = bf_lo(g2.x), g1 = bf_hi(g2.x), g2f = bf_lo(g2.y), g3 = bf_hi(g2.y);
                if (!S1_SILU) { g0 = fsilu(g0); g1 = fsilu(g1); g2f = fsilu(g2f); g3 = fsilu(g3); }
                u32x2 pk; pk.x = cvt_pk_bf16(ov[0] * rstd * gn[vv2][0] * g0, ov[1] * rstd * gn[vv2][1] * g1);
                pk.y = cvt_pk_bf16(ov[2] * rstd * gn[vv2][2] * g2f, ov[3] * rstd * gn[vv2][3] * g3);
                *(u32x2*)(YB + o) = pk; } }
    }
    __syncthreads();
}

constexpr int LR_XCS = 0, LR_XCT = 17408, LR_GAT = 35840, LR_YAS = 54272;
__device__ __forceinline__ void lru_item(const Params& P, LAS unsigned char* lds, int b, int blk, int w, int l, bf16* YA) {
    const bf16* XA = (const bf16*)(P.ws + WS_XA); const bf16* GA = (const bf16*)(P.ws + WS_GA);
    const bf16* GBT = (const bf16*)(P.ws + WS_MISC + MS_GBT); const float* sp8 = (const float*)(P.ws + WS_MISC + MS_SP8);
    const int fr = l & 15, fq = l >> 4, c0 = 2 * l, chg = blk * 128;
    float cw[4][2], cb[2];
#pragma unroll
    for (int c = 0; c < 2; ++c) { cb[c] = P.conv_b[chg + c0 + c];
#pragma unroll
        for (int k = 0; k < 4; ++k) cw[k][c] = P.conv_w[k * D + chg + c0 + c]; }
    bf16x8 wfx[4], wfa[4];
#pragma unroll
    for (int ks = 0; ks < 4; ++ks) { const bf16* r = GBT + (size_t)(256 * blk + 16 * w + fr) * 256 + 128 * (blk & 1) + 32 * ks + 8 * fq;
        wfx[ks] = *(const bf16x8*)r; wfa[ks] = *(const bf16x8*)(r + 128 * 256); }
    const int ch = chg + 16 * w + fr;
    const float bxv = P.rg_bx[ch], bav = P.rg_ba[ch], spv = sp8[ch] * L2E;
    float hc = 0.f;
    const size_t row0 = (size_t)b * SEQ; const int col = chg + c0;
    unsigned rx[11], rg[8];
#pragma unroll
    for (int i = 0; i < 11; ++i) { const int tp = 8 * w + i - 3; rx[i] = (tp >= 0) ? *(const unsigned*)(XA + (row0 + tp) * D + col) : 0u; }
#pragma unroll
    for (int tt = 0; tt < 8; ++tt) rg[tt] = *(const unsigned*)(GA + (row0 + 8 * w + tt) * D + col);
    __syncthreads();
    for (int n = 0; n < 32; ++n) {
        const size_t crow = row0 + (size_t)n * 64;
        float xc[8][2];
#pragma unroll
        for (int tt = 0; tt < 8; ++tt)
#pragma unroll
            for (int c = 0; c < 2; ++c) { float a = cb[c];
#pragma unroll
                for (int k = 0; k < 4; ++k) a += cw[k][c] * (c ? bf_hi(rx[tt + k]) : bf_lo(rx[tt + k]));
                xc[tt][c] = a; }
#pragma unroll
        for (int tt = 0; tt < 8; ++tt) *(LAS unsigned*)(lds + LR_XCS + (8 * w + tt) * 272 + c0 * 2) = cvt_pk_bf16(xc[tt][0], xc[tt][1]);
#pragma unroll
        for (int c = 0; c < 2; ++c) {
            u32x4 px, pg;
            px.x = cvt_pk_bf16(xc[0][c], xc[1][c]); px.y = cvt_pk_bf16(xc[2][c], xc[3][c]); px.z = cvt_pk_bf16(xc[4][c], xc[5][c]); px.w = cvt_pk_bf16(xc[6][c], xc[7][c]);
            if (c == 0) { pg.x = (rg[0] & 0xffffu) | (rg[1] << 16); pg.y = (rg[2] & 0xffffu) | (rg[3] << 16); pg.z = (rg[4] & 0xffffu) | (rg[5] << 16); pg.w = (rg[6] & 0xffffu) | (rg[7] << 16); }
            else        { pg.x = (rg[0] >> 16) | (rg[1] & 0xffff0000u); pg.y = (rg[2] >> 16) | (rg[3] & 0xffff0000u); pg.z = (rg[4] >> 16) | (rg[5] & 0xffff0000u); pg.w = (rg[6] >> 16) | (rg[7] & 0xffff0000u); }
            *(LAS u32x4*)(lds + LR_XCT + (c0 + c) * 144 + w * 16) = px;
            *(LAS u32x4*)(lds + LR_GAT + (c0 + c) * 144 + w * 16) = pg;
        }
        { const size_t nrow = (n < 31) ? crow + 64 : crow;
#pragma unroll
            for (int i = 0; i < 11; ++i) rx[i] = *(const unsigned*)(XA + (nrow + 8 * w + i - 3) * D + col);
#pragma unroll
            for (int tt = 0; tt < 8; ++tt) rg[tt] = *(const unsigned*)(GA + (nrow + 8 * w + tt) * D + col);
        }
        __syncthreads();
        f32x4 ax[4], aa[4];
#pragma unroll
        for (int tj = 0; tj < 4; ++tj) { ax[tj] = (f32x4){0.f, 0.f, 0.f, 0.f}; aa[tj] = ax[tj];
#pragma unroll
            for (int ks = 0; ks < 4; ++ks) { const bf16x8 xf = lds_frag(lds + LR_XCS + (16 * tj + fr) * 272 + ks * 64 + fq * 16);
                ax[tj] = __builtin_amdgcn_mfma_f32_16x16x32_bf16(xf, wfx[ks], ax[tj], 0, 0, 0);
                aa[tj] = __builtin_amdgcn_mfma_f32_16x16x32_bf16(xf, wfa[ks], aa[tj], 0, 0, 0); } }
#pragma unroll
        for (int tj = 0; tj < 4; ++tj) {
            const u32x2 xp = *(const LAS u32x2*)(lds + LR_XCT + (16 * w + fr) * 144 + (16 * tj + 4 * fq) * 2);
            const u32x2 gp = *(const LAS u32x2*)(lds + LR_GAT + (16 * w + fr) * 144 + (16 * tj + 4 * fq) * 2);
            const float xv[4] = {bf_lo(xp.x), bf_hi(xp.x), bf_lo(xp.y), bf_hi(xp.y)}, gv[4] = {bf_lo(gp.x), bf_hi(gp.x), bf_lo(gp.y), bf_hi(gp.y)};
            float hl[4], Ac[4];
#pragma unroll
            for (int j = 0; j < 4; ++j) {
                const float gi = fsigmoid(ax[tj][j] + bxv), gr = fsigmoid(aa[tj][j] + bav);
                const float a = __builtin_amdgcn_exp2f(-gr * spv);
                const float u = __builtin_amdgcn_sqrtf(fmaxf(1.0f - a * a, 0.f)) * gi * xv[j];
                hl[j] = j ? a * hl[j - 1] + u : u; Ac[j] = j ? a * Ac[j - 1] : a;
            }
            float Ag = Ac[3], Hg = hl[3];
            { const float A1 = __shfl_up(Ag, 16), H1 = __shfl_up(Hg, 16); if (fq >= 1) { Hg = Ag * H1 + Hg; Ag = Ag * A1; } }
            { const float A2 = __shfl_up(Ag, 32), H2 = __shfl_up(Hg, 32); if (fq >= 2) { Hg = Ag * H2 + Hg; Ag = Ag * A2; } }
            float Ae = __shfl_up(Ag, 16), He = __shfl_up(Hg, 16); if (fq == 0) { Ae = 1.f; He = 0.f; }
            const float At = __shfl(Ag, 48 + fr), Ht = __shfl(Hg, 48 + fr);
            const float hstart = Ae * hc + He;
#pragma unroll
            for (int j = 0; j < 4; ++j) { const float y = (hl[j] + Ac[j] * hstart) * fsilu(gv[j]);
                *(LAS unsigned short*)(lds + LR_YAS + (16 * tj + 4 * fq + j) * 272 + (16 * w + fr) * 2) = (unsigned short)(cvt_pk_bf16(y, 0.f) & 0xffffu); }
            hc = At * hc + Ht;
        }
        asm volatile("s_waitcnt vmcnt(0)" ::: "memory");
        __syncthreads();
#pragma unroll
        for (int tt = 0; tt < 8; ++tt) *(unsigned*)(YA + (crow + 8 * w + tt) * D + col) = *(const LAS unsigned*)(lds + LR_YAS + (8 * w + tt) * 272 + c0 * 2);
    }
    __syncthreads();
}

#define XB_TMO      128
#define XB_XCNT(j)  (256  + 64 * (j))
#define XB_XSUB(j)  (1280 + 64 * (j))
#define XB_XGEN(j)  (2304 + 64 * (j))
#define XB_TOP      3328
#define XB_TOPGEN   3392
#define XCD_BAR_WORDS 3456
#define XB_SPIN_CAP (1u << 18)

__device__ __forceinline__ unsigned xb_ld(unsigned* p)              { return __hip_atomic_load(p, __ATOMIC_RELAXED, __HIP_MEMORY_SCOPE_AGENT); }
__device__ __forceinline__ unsigned xb_add(unsigned* p, unsigned v) { return __hip_atomic_fetch_add(p, v, __ATOMIC_RELAXED, __HIP_MEMORY_SCOPE_AGENT); }
__device__ __forceinline__ unsigned xb_xcc_id() { return (unsigned)__builtin_amdgcn_s_getreg((3 << 11) | 20) & 0xFu; }
#define XB_SPIN(cond, bar) do { unsigned _sp = 0; while (cond) { __builtin_amdgcn_s_sleep(1); \
    if ((++_sp & 255u) == 0u) { if (xb_ld(&(bar)[XB_TMO])) break; if (_sp > XB_SPIN_CAP) { atomicAdd(&(bar)[XB_TMO], 1u); break; } } } } while (0)

struct XcdBarrier {
    unsigned* bar; unsigned x;
    volatile LAS unsigned* st;
};

__device__ __forceinline__ XcdBarrier xcd_barrier_post(unsigned* bar, volatile LAS unsigned* st) {
    XcdBarrier b; b.bar = bar; b.x = xb_xcc_id(); b.st = st;
    if (threadIdx.x == 0) (void)xb_add(&bar[XB_XCNT(b.x)], 1u);
    return b;
}
__device__ __forceinline__ void xcd_barrier_complete(unsigned* bar, unsigned x, unsigned& nloc, unsigned& nx) {
    const unsigned G = gridDim.x * gridDim.y * gridDim.z;
    unsigned sum, cnt, mine, sp = 0u;
    for (;;) {
        sum = 0u; cnt = 0u; mine = 0u;
#pragma unroll
        for (unsigned j = 0; j < 16; ++j) { const unsigned c = xb_ld(&bar[XB_XCNT(j)]); sum += c; cnt += (c > 0u) ? 1u : 0u; mine = (j == x) ? c : mine; }
        if (sum == G) break;
        __builtin_amdgcn_s_sleep(1);
        if ((++sp & 255u) == 0u) { if (xb_ld(&bar[XB_TMO])) break; if (sp > XB_SPIN_CAP) { atomicAdd(&bar[XB_TMO], 1u); break; } }
    }
    nloc = mine > 0u ? mine : 1u; nx = cnt > 0u ? cnt : 1u;
}

__device__ __forceinline__ void xcd_barrier(const XcdBarrier& b) {
    asm volatile("s_waitcnt vmcnt(0)" ::: "memory");
    __syncthreads();
    if (threadIdx.x == 0) {
        unsigned* bar = b.bar;
        __builtin_amdgcn_s_waitcnt(0);
        unsigned nloc = b.st[0], nx = b.st[1];
        if (nloc == 0u) { xcd_barrier_complete(bar, b.x, nloc, nx); b.st[0] = nloc; b.st[1] = nx; }
        const unsigned old = xb_add(&bar[XB_XSUB(b.x)], 1u);
        const unsigned gen = old / nloc;
        if (old + 1u == (gen + 1u) * nloc) {
            __builtin_amdgcn_fence(__ATOMIC_RELEASE, "agent");
            asm volatile("s_waitcnt vmcnt(0)" ::: "memory");
            const unsigned og = xb_add(&bar[XB_TOP], 1u);
            const unsigned tg = og / nx;
            if (og + 1u == (tg + 1u) * nx) xb_add(&bar[XB_TOPGEN], 1u);
            else XB_SPIN(xb_ld(&bar[XB_TOPGEN]) == tg, bar);
            __builtin_amdgcn_fence(__ATOMIC_ACQUIRE, "agent");
            xb_add(&bar[XB_XGEN(b.x)], 1u);
            asm volatile("s_waitcnt vmcnt(0)" ::: "memory");
        } else {
            XB_SPIN(xb_ld(&bar[XB_XGEN(b.x)]) == gen, bar);
            __builtin_amdgcn_fence(__ATOMIC_ACQUIRE, "agent");
            asm volatile("s_waitcnt vmcnt(0)" ::: "memory");
        }
    }
    __syncthreads();
}


constexpr int P6A_LRU_TILES = 3;
__global__ void __launch_bounds__(512, 2) hawk_hgrn2_fwd(Params P) {
    extern __shared__ __attribute__((aligned(16))) unsigned char lds_raw[];
    LAS unsigned char* lds = (LAS unsigned char*)lds_raw;
    cg::grid_group grid = cg::this_grid();
#define GRID_SYNC() xcd_barrier(xbar_)
#define PHASE_IDS() int tid = threadIdx.x; asm volatile("" : "+v"(tid)); const int lane = tid & 63, wave = __builtin_amdgcn_readfirstlane(tid >> 6); (void)lane; (void)wave
    const int G = gridDim.x;
    volatile LAS unsigned* xst_ = (volatile LAS unsigned*)(lds + (LDS_BYTES - 64));
    if (threadIdx.x < 16) xst_[threadIdx.x] = 0u;
    __syncthreads();
    const XcdBarrier xbar_ = xcd_barrier_post(P.bar, xst_);
    unsigned char* ws = P.ws; unsigned char* ms = ws + WS_MISC;
    bf16* const dH = (bf16*)(ws + WS_H); bf16* const dXA = (bf16*)(ws + WS_XA); bf16* const dGA = (bf16*)(ws + WS_GA); bf16* const dQ = (bf16*)(ws + WS_Q);
    bf16* const dF = (bf16*)(ws + WS_F); bf16* const dI = (bf16*)(ws + WS_I);
    bf16* const dGMA0 = (bf16*)P.out; bf16* const dGMB0 = (bf16*)P.out + (size_t)M * D;
    const bf16* WinT = (const bf16*)(ms + MS_WIN);

    if (P.use_cg_sync) grid.sync();
    { PHASE_IDS(); p0_prologue(P, lds, wave, lane); }
    GRID_SYNC();
    { pg8::Gemm g{dH, WinT, M, 8192, D, D, 0, 0};
      pg8::EpiBf16<2> E{dXA, (size_t)M * D, nullptr, P.b_merge, dGMA0, dGMB0};
      { pg8::StaticOrder S; S.init(M, 8192, G, (int)blockIdx.x); pg8::gemm_phase<pg8::EpiBf16<2>, pg8::StaticOrder, true, true>(lds, g, S, E); }
    }
    GRID_SYNC();
    { const int nh = G / 2;
      PHASE_IDS();
      if ((int)blockIdx.x < nh) {
        for (int it = blockIdx.x; it < NB * NHEAD; it += nh) hgrn_item2(P, lds, it >> 3, it & 7, wave, lane, dQ);
        { __syncthreads();
          if (threadIdx.x == 0) { unsigned* hb = P.bar + 3840 + 16 * ((int)blockIdx.x >> 3); unsigned sp = 0;
              while (__hip_atomic_load(hb, __ATOMIC_RELAXED, __HIP_MEMORY_SCOPE_AGENT) < 8u && ++sp < (1u << 22)) __builtin_amdgcn_s_sleep(2);
              __builtin_amdgcn_fence(__ATOMIC_ACQUIRE, "agent"); asm volatile("s_waitcnt vmcnt(0)" ::: "memory"); }
          __syncthreads(); }
        { pg8::Gemm g{dXA, (const bf16*)(ms + MS_PA), M, D, D, D, 0, 0}; pg8::ColOrder S{(int)blockIdx.x, P6A_LRU_TILES, 4 - P6A_LRU_TILES};
          pg8::EpiGate<0> E{dGMA0, nullptr, dH, P.b_merge};
          pg8::gemm_phase<pg8::EpiGate<0>, pg8::ColOrder, true, true>(lds, g, S, E); } }
      else {
        for (int it = (int)blockIdx.x - nh; it < NB * 8; it += G - nh) lru_item(P, lds, it >> 3, it & 7, wave, lane, dXA);
        { asm volatile("s_waitcnt vmcnt(0) lgkmcnt(0)" ::: "memory"); __syncthreads();
          if (threadIdx.x == 0) { __builtin_amdgcn_fence(__ATOMIC_RELEASE, "agent"); asm volatile("s_waitcnt vmcnt(0)" ::: "memory");
              unsigned* hb = P.bar + 3840 + 16 * (((int)blockIdx.x - nh) >> 3);
              __hip_atomic_fetch_add(hb, 1u, __ATOMIC_RELAXED, __HIP_MEMORY_SCOPE_AGENT);
              unsigned sp = 0; while (__hip_atomic_load(hb, __ATOMIC_RELAXED, __HIP_MEMORY_SCOPE_AGENT) < 8u && ++sp < (1u << 22)) __builtin_amdgcn_s_sleep(2);
              __builtin_amdgcn_fence(__ATOMIC_ACQUIRE, "agent"); asm volatile("s_waitcnt vmcnt(0)" ::: "memory"); }
          __syncthreads(); }
        { pg8::Gemm g{dXA, (const bf16*)(ms + MS_PA), M, D, D, D, 0, 0}; pg8::ColOrder S{(int)blockIdx.x - nh, 0, P6A_LRU_TILES};
          pg8::EpiGate<0> E{dGMA0, nullptr, dH, P.b_merge};
          pg8::gemm_phase<pg8::EpiGate<0>, pg8::ColOrder, true, true>(lds, g, S, E); } } }
    GRID_SYNC();
    { pg8::Gemm g{dQ, (const bf16*)(ms + MS_PB), M, D, D, D, 0, 0}; pg8::PanelOrder S; S.init(M, G, (int)blockIdx.x);
      pg8::EpiGate<1> E{dGMB0, dH, dF, P.b_merge + D};
      pg8::gemm_phase<pg8::EpiGate<1>, pg8::PanelOrder, true, true>(lds, g, S, E); }
    GRID_SYNC();
    { pg8::Gemm g{dF, (const bf16*)(ms + MS_WO), M, D, D, D, 0, 0}; pg8::PanelOrder S; S.init(M, G, (int)blockIdx.x);
      pg8::EpiFinal E{P.x, P.out, P.final_g, (float*)(ms + MS_PART), (unsigned*)(ms + MS_CNT), lds + 131072};
      pg8::gemm_phase<pg8::EpiFinal, pg8::PanelOrder, true, true>(lds, g, S, E); }
}

extern "C" void kernel_launch(void* const* d_in, const int* in_sizes, int n_in, void* d_out, int out_size, void* d_ws, size_t ws_size, hipStream_t stream) {
    static int grid = 0;
    if (!grid) {
        if (n_in != 17 || in_sizes[0] != M * D || out_size != M * D || ws_size < WS_NEED) {
            fprintf(stderr, "kernel_launch: unexpected shapes: n_in %d in0 %d out %d ws %zu (need %zu); nothing launched\n", n_in, n_in > 0 ? in_sizes[0] : -1, out_size, ws_size, (size_t)WS_NEED); grid = -1; return; }
        int dev = 0, cus = 0, per_cu = 0;
        if (hipGetDevice(&dev) != hipSuccess || hipDeviceGetAttribute(&cus, hipDeviceAttributeMultiprocessorCount, dev) != hipSuccess) { grid = -1; return; }
        if (hipFuncSetAttribute((const void*)hawk_hgrn2_fwd, hipFuncAttributeMaxDynamicSharedMemorySize, LDS_BYTES) != hipSuccess) { fprintf(stderr, "kernel_launch: hipFuncSetAttribute failed\n"); grid = -1; return; }
        if (hipOccupancyMaxActiveBlocksPerMultiprocessor(&per_cu, (const void*)hawk_hgrn2_fwd, 512, LDS_BYTES) != hipSuccess || per_cu < 1) { fprintf(stderr, "kernel_launch: occupancy query says %d\n", per_cu); }
        if (cus < 256) { fprintf(stderr, "kernel_launch: this build needs 256 co-resident workgroups (one per CU); the device has %d CUs; nothing launched\n", cus); grid = -1; return; }
        grid = 256;
    }
    if (grid <= 0) return;
    Params p{};
    p.x = (const float*)d_in[0]; p.w_in = (const float*)d_in[1]; p.b_merge = (const float*)d_in[2]; p.conv_w = (const float*)d_in[3]; p.conv_b = (const float*)d_in[4];
    p.rg_wx = (const float*)d_in[5]; p.rg_bx = (const float*)d_in[6]; p.rg_wa = (const float*)d_in[7]; p.rg_ba = (const float*)d_in[8]; p.rg_lambda = (const float*)d_in[9];
    p.hg_lb = (const float*)d_in[10]; p.hg_norm_g = (const float*)d_in[11]; p.proj_a = (const float*)d_in[12]; p.proj_b = (const float*)d_in[13]; p.w_out = (const float*)d_in[14];
    p.norm_g = (const float*)d_in[15]; p.final_g = (const float*)d_in[16];
    p.out = (float*)d_out; p.ws = (unsigned char*)d_ws; p.bar = (unsigned*)((unsigned char*)d_ws + WS_MISC + MS_BAR); p.use_cg_sync = 0; p.pad = 0;
    if (hipMemsetAsync(p.bar, 0, 16384, stream) != hipSuccess) { fprintf(stderr, "kernel_launch: memset failed\n"); return; }
    void* args[] = {&p};
    hipError_t e = hipLaunchCooperativeKernel((const void*)hawk_hgrn2_fwd, dim3(grid), dim3(512), args, LDS_BYTES, stream);
    if (e != hipSuccess) fprintf(stderr, "kernel_launch: cooperative launch failed: %s (grid %d)\n", hipGetErrorString(e), grid);
}
```

```cpp
#include <hip/hip_runtime.h>
#include <hip/hip_cooperative_groups.h>
#include <cstdio>
#include <cstdint>
namespace cg = cooperative_groups;

#ifndef GATE_SIG_IN_S1
#define GATE_SIG_IN_S1 0
#endif
#ifndef S1_SILU
#define S1_SILU 0
#endif
namespace pg8 {
#define PG8_LAS __attribute__((address_space(3)))
typedef unsigned short bf16_t;
typedef short bf16x8 __attribute__((ext_vector_type(8)));
typedef float f32x4 __attribute__((ext_vector_type(4)));
typedef unsigned u32x4 __attribute__((ext_vector_type(4)));
typedef unsigned u32x2 __attribute__((ext_vector_type(2)));
constexpr int BM = 256, BK = 64, HALF = 128, HTB = HALF * BK * 2  , STAGE_BYTES = 8 * HTB, NXCD = 8, WGM = 8;

__host__ __device__ __forceinline__ int lds_byte(int r, int c) { const int st = (r >> 4) * 2 + (c >> 5), rr = r & 15, cc = c & 31, ob = rr * 64 + cc * 2; return st * 1024 + (ob ^ (((ob >> 9) & 1) << 5)); }
__host__ __device__ __forceinline__ void stage_rc(int b, int& R, int& C) { const int st = b / 1024, sb = b % 1024, swz = sb ^ (((sb >> 9) & 1) << 5); R = (st >> 1) * 16 + swz / 64; C = (st & 1) * 32 + (swz % 64) / 2; }
__host__ __device__ __forceinline__ int perm32(int rho) { const int n = rho >> 4, i = rho & 15; return 8 * (i >> 2) + 4 * n + (i & 3); }

struct Unit { int pm, pn; };
struct Gemm { const bf16_t* A; const bf16_t* Bt; int M, N, K, lda, apn_shift, apn_bytes; };

struct StaticOrder {
    int nM, nN, nwg, G, c;
    __host__ __device__ void init(int M, int N, int G_, int c_) { nM = M / BM; nN = N / BM; nwg = nM * nN; G = G_; c = c_; }
    __host__ __device__ bool next(int i, Unit& u) const {
        const long L = (long)i * G + c; if (L >= nwg) return false;
        int wgid = (int)L; { const int q = nwg / NXCD, r = nwg % NXCD, xcd = wgid % NXCD, off = wgid / NXCD; wgid = (xcd < r ? xcd * (q + 1) : r * (q + 1) + (xcd - r) * q) + off; }
        const int nig = WGM * nN, gid = wgid / nig, fm = gid * WGM, gsz = (nM - fm) < WGM ? (nM - fm) : WGM;
        u.pm = fm + ((wgid % nig) % gsz); u.pn = (wgid % nig) / gsz; return true;
    }
    __device__ __forceinline__ void a_ready(const Unit&) const {}
    __device__ __forceinline__ void done(const Unit&) const {}
};

typedef float f32x2_t __attribute__((ext_vector_type(2)));
typedef __bf16 bf16x2_t __attribute__((ext_vector_type(2)));
__device__ __forceinline__ unsigned cvt_pk_bf16(float lo, float hi) { const f32x2_t v = {lo, hi}; const bf16x2_t b = __builtin_convertvector(v, bf16x2_t); return __builtin_bit_cast(unsigned, b); }
struct ColOrder {
    int pm, pn0, npn;
    __host__ __device__ bool next(int i, Unit& u) const { if (i >= npn) return false; u.pm = pm; u.pn = pn0 + i; return true; }
    __device__ __forceinline__ void a_ready(const Unit&) const {}
    __device__ __forceinline__ void done(const Unit&) const {}
};
__device__ __forceinline__ float bf_lo(unsigned w) { return __builtin_bit_cast(float, w << 16); }
__device__ __forceinline__ float bf_hi(unsigned w) { return __builtin_bit_cast(float, w & 0xffff0000u); }
__device__ __forceinline__ float fsigmoid(float x) { return __builtin_amdgcn_rcpf(1.0f + __builtin_amdgcn_exp2f(-1.44269504089f * x)); }
__device__ __forceinline__ u32x4 pack8(f32x4 v0, f32x4 v1) { u32x4 w; w.x = cvt_pk_bf16(v0[0], v0[1]); w.y = cvt_pk_bf16(v0[2], v0[3]); w.z = cvt_pk_bf16(v1[0], v1[1]); w.w = cvt_pk_bf16(v1[2], v1[3]); return w; }
__device__ __forceinline__ void unpack8(u32x4 w, f32x4& v0, f32x4& v1) { v0 = (f32x4){bf_lo(w.x), bf_hi(w.x), bf_lo(w.y), bf_hi(w.y)}; v1 = (f32x4){bf_lo(w.z), bf_hi(w.z), bf_lo(w.w), bf_hi(w.w)}; }

template <int ACT> struct EpiBf16 {
    static constexpr bool PERM = true, AFTER_DRAIN = false;
    bf16_t* O; size_t split_stride; bf16_t* O1; const float* bias; bf16_t* O6; bf16_t* O7;
    __device__ __forceinline__ void operator()(const f32x4 (&acc)[2][2][4][2], const Unit& u, int, int, int, int) const {
        int t_ = threadIdx.x; asm volatile("" : "+v"(t_));
        const int wid_ = t_ >> 6, wr = wid_ >> 2, wc = wid_ & 3, fr = t_ & 15, fq = (t_ >> 4) & 3;
        const int row0 = u.pm * BM + wr * 64 + fr; int colt = u.pn * BM; const int t = colt >> 10; colt &= 1023;
        bf16_t* base = (t == 1 && O1) ? O1 : O + (size_t)t * split_stride;
        if (ACT == 2) { if (t == 6) base = O6; if (t == 7) base = O7; }
        const int col0 = colt + wc * 32 + 8 * fq, bcol0 = u.pn * BM + wc * 32 + 8 * fq - (ACT == 2 ? 6144 : 0);
        const bool has_bias = (ACT == 1) || (ACT == 2 && GATE_SIG_IN_S1 && t >= 6);
        f32x4 bv[2][2];
#pragma unroll
        for (int bj = 0; bj < 2; ++bj)
#pragma unroll
            for (int n = 0; n < 2; ++n) bv[bj][n] = has_bias ? *(const f32x4*)(bias + bcol0 + bj * HALF + 4 * n) : (f32x4){0.f, 0.f, 0.f, 0.f};
#pragma unroll
        for (int ai = 0; ai < 2; ++ai)
#pragma unroll
            for (int m = 0; m < 4; ++m) { bf16_t* rowp = base + (size_t)(row0 + ai * HALF + m * 16) * 1024 + col0;
#pragma unroll
                for (int bj = 0; bj < 2; ++bj) { f32x4 v0 = acc[ai][bj][m][0] + bv[bj][0], v1 = acc[ai][bj][m][1] + bv[bj][1];
                    if (ACT == 1) {
#pragma unroll
                        for (int i = 0; i < 4; ++i) { v0[i] = fsigmoid(v0[i]); v1[i] = fsigmoid(v1[i]); } }
                    if (ACT == 2) { if (GATE_SIG_IN_S1 && t >= 6) {
#pragma unroll
                        for (int i = 0; i < 4; ++i) { v0[i] = fsigmoid(v0[i]); v1[i] = fsigmoid(v1[i]); } }
                      if (S1_SILU && (t == 2 || t == 5)) { const float sc = (t == 2) ? 0.08838834764831845f : 1.0f;
#pragma unroll
                        for (int i = 0; i < 4; ++i) { v0[i] = v0[i] * fsigmoid(v0[i]) * sc; v1[i] = v1[i] * fsigmoid(v1[i]) * sc; } } }
                    if (ACT == 2) __builtin_nontemporal_store(pack8(v0, v1), (u32x4*)(rowp + bj * HALF));
                    else *(u32x4*)(rowp + bj * HALF) = pack8(v0, v1); } }
    }
};
template <int MODE> struct EpiGate {
    static constexpr bool PERM = true, AFTER_DRAIN = false;
    const bf16_t* G; const bf16_t* T; bf16_t* O; const float* gbias;
    __device__ __forceinline__ void operator()(const f32x4 (&acc)[2][2][4][2], const Unit& u, int, int, int, int) const {
        int t_ = threadIdx.x; asm volatile("" : "+v"(t_));
        const int wid_ = t_ >> 6, wr = wid_ >> 2, wc = wid_ & 3, fr = t_ & 15, fq = (t_ >> 4) & 3;
        const int row0 = u.pm * BM + wr * 64 + fr, col0 = u.pn * BM + wc * 32 + 8 * fq;
        f32x4 gb_[2][2];
#pragma unroll
        for (int bj = 0; bj < 2; ++bj)
#pragma unroll
            for (int n = 0; n < 2; ++n) gb_[bj][n] = GATE_SIG_IN_S1 ? (f32x4){0.f, 0.f, 0.f, 0.f} : *(const f32x4*)(gbias + col0 + bj * HALF + 4 * n);
#pragma unroll
        for (int ai = 0; ai < 2; ++ai)
#pragma unroll
            for (int m = 0; m < 4; ++m) { const size_t ro = (size_t)(row0 + ai * HALF + m * 16) * 1024 + col0;
#pragma unroll
                for (int bj = 0; bj < 2; ++bj) {
                    f32x4 g0, g1; unpack8(__builtin_nontemporal_load((const u32x4*)(G + ro + bj * HALF)), g0, g1);
                    if (!GATE_SIG_IN_S1) {
#pragma unroll
                        for (int i = 0; i < 4; ++i) { g0[i] = fsigmoid(g0[i] + gb_[bj][0][i]); g1[i] = fsigmoid(g1[i] + gb_[bj][1][i]); } }
                    f32x4 v0 = acc[ai][bj][m][0] * g0, v1 = acc[ai][bj][m][1] * g1;
                    if (MODE == 1) { f32x4 t0, t1; unpack8(__builtin_nontemporal_load((const u32x4*)(T + ro + bj * HALF)), t0, t1); v0 = v0 + t0; v1 = v1 + t1; }
                    *(u32x4*)(O + ro + bj * HALF) = pack8(v0, v1); } }
    }
};
struct EpiResid {
    static constexpr bool PERM = true, AFTER_DRAIN = false;
    const float* X; float* O;
    __device__ __forceinline__ void operator()(const f32x4 (&acc)[2][2][4][2], const Unit& u, int, int, int, int) const {
        int t_ = threadIdx.x; asm volatile("" : "+v"(t_));
        const int wid_ = t_ >> 6, wr = wid_ >> 2, wc = wid_ & 3, fr = t_ & 15, fq = (t_ >> 4) & 3;
        const int row0 = u.pm * BM + wr * 64 + fr, col0 = u.pn * BM + wc * 32 + 8 * fq;
#pragma unroll
        for (int ai = 0; ai < 2; ++ai)
#pragma unroll
            for (int m = 0; m < 4; ++m) { const size_t ro = (size_t)(row0 + ai * HALF + m * 16) * 1024 + col0;
#pragma unroll
                for (int bj = 0; bj < 2; ++bj) {
                    const f32x4 x0 = *(const f32x4*)(X + ro + bj * HALF), x1 = *(const f32x4*)(X + ro + bj * HALF + 4);
                    *(f32x4*)(O + ro + bj * HALF) = x0 + acc[ai][bj][m][0]; *(f32x4*)(O + ro + bj * HALF + 4) = x1 + acc[ai][bj][m][1]; } }
    }
};

struct PanelOrder {
    int nwg, G, c;
    __host__ __device__ void init(int M, int G_, int c_) { nwg = (M / BM) * 4; G = G_; c = c_; }
    __host__ __device__ bool next(int i, Unit& u) const { const long L = (long)i * G + c; if (L >= nwg) return false;
        if ((G & 31) != 0) { u.pm = (int)(L >> 2); u.pn = (int)(L & 3); return true; }
        const int x = c & 7, k = c >> 3; u.pn = k & 3; u.pm = i * (G >> 2) + (k >> 2) * 8 + x; return true; }
    __device__ __forceinline__ void a_ready(const Unit&) const {}
    __device__ __forceinline__ void done(const Unit&) const {}
};
struct EpiFinal {
    static constexpr bool PERM = true, AFTER_DRAIN = false;
    const float* X; float* O; const float* gain; float* part; unsigned* cnt; PG8_LAS unsigned char* scr;
    __device__ __forceinline__ void operator()(f32x4 (&acc)[2][2][4][2], const Unit& u, int, int, int, int) const {
        int t_ = threadIdx.x; asm volatile("" : "+v"(t_));
        const int wid_ = t_ >> 6, wr = wid_ >> 2, wc = wid_ & 3, fr = t_ & 15, fq = (t_ >> 4) & 3;
        const int row0 = u.pm * BM + wr * 64 + fr, col0 = u.pn * BM + wc * 32 + 8 * fq;
        PG8_LAS float* ssl = (PG8_LAS float*)scr; PG8_LAS float* rstd_l = (PG8_LAS float*)(scr + 4096);
#pragma unroll
        for (int ai = 0; ai < 2; ++ai)
#pragma unroll
            for (int m = 0; m < 4; ++m) { const size_t ro = (size_t)(row0 + ai * HALF + m * 16) * 1024 + col0; float s = 0.f;
#pragma unroll
                for (int bj = 0; bj < 2; ++bj) {
                    const f32x4 x0 = __builtin_nontemporal_load((const f32x4*)(X + ro + bj * HALF)), x1 = __builtin_nontemporal_load((const f32x4*)(X + ro + bj * HALF + 4));
                    acc[ai][bj][m][0] = acc[ai][bj][m][0] + x0; acc[ai][bj][m][1] = acc[ai][bj][m][1] + x1;
#pragma unroll
                    for (int n = 0; n < 2; ++n) { const f32x4 v = acc[ai][bj][m][n]; s += (v[0] * v[0] + v[1] * v[1]) + (v[2] * v[2] + v[3] * v[3]); } }
                s += __shfl_xor(s, 16); s += __shfl_xor(s, 32);
                if (fq == 0) ssl[((wr * 4 + wc) * 8 + ai * 4 + m) * 16 + fr] = s; }
        asm volatile("s_waitcnt lgkmcnt(0)" ::: "memory"); __builtin_amdgcn_s_barrier(); asm volatile("" ::: "memory");
        const int rr = t_ & 255, r_ai = rr >> 7, r_wr = (rr >> 6) & 1, r_m = (rr >> 4) & 3, r_fr = rr & 15;
        if (t_ < 256) { float s = 0.f;
#pragma unroll
            for (int c = 0; c < 4; ++c) s += ssl[((r_wr * 4 + c) * 8 + r_ai * 4 + r_m) * 16 + r_fr];
            __hip_atomic_store(part + (size_t)(u.pm * 4 + u.pn) * 256 + rr, s, __ATOMIC_RELAXED, __HIP_MEMORY_SCOPE_AGENT);
            asm volatile("s_waitcnt vmcnt(0)" ::: "memory"); }
        asm volatile("s_waitcnt lgkmcnt(0)" ::: "memory"); __builtin_amdgcn_s_barrier(); asm volatile("" ::: "memory");
        if (t_ == 0) { __hip_atomic_fetch_add(cnt + u.pm, 1u, __ATOMIC_RELAXED, __HIP_MEMORY_SCOPE_AGENT);
            unsigned sp = 0; while (__hip_atomic_load(cnt + u.pm, __ATOMIC_RELAXED, __HIP_MEMORY_SCOPE_AGENT) < 4u && ++sp < (1u << 22)) __builtin_amdgcn_s_sleep(2); }
        asm volatile("s_waitcnt vmcnt(0) lgkmcnt(0)" ::: "memory"); __builtin_amdgcn_s_barrier(); asm volatile("" ::: "memory");
        if (t_ < 256) { float s = 0.f;
#pragma unroll
            for (int c = 0; c < 4; ++c) s += __hip_atomic_load(part + (size_t)(u.pm * 4 + c) * 256 + rr, __ATOMIC_RELAXED, __HIP_MEMORY_SCOPE_AGENT);
            rstd_l[rr] = 1.0f / sqrtf(s * (1.0f / 1024.0f) + 1e-6f); }
        asm volatile("s_waitcnt vmcnt(0) lgkmcnt(0)" ::: "memory"); __builtin_amdgcn_s_barrier(); asm volatile("" ::: "memory");
        f32x4 gv[2][2];
#pragma unroll
        for (int bj = 0; bj < 2; ++bj)
#pragma unroll
            for (int n = 0; n < 2; ++n) gv[bj][n] = *(const f32x4*)(gain + col0 + bj * HALF + 4 * n);
#pragma unroll
        for (int ai = 0; ai < 2; ++ai)
#pragma unroll
            for (int m = 0; m < 4; ++m) { const size_t ro = (size_t)(row0 + ai * HALF + m * 16) * 1024 + col0; const float rs = rstd_l[ai * 128 + wr * 64 + m * 16 + fr];
#pragma unroll
                for (int bj = 0; bj < 2; ++bj) { *(f32x4*)(O + ro + bj * HALF) = (acc[ai][bj][m][0] * rs) * gv[bj][0]; *(f32x4*)(O + ro + bj * HALF + 4) = (acc[ai][bj][m][1] * rs) * gv[bj][1]; } }
        asm volatile("s_waitcnt lgkmcnt(0)" ::: "memory");
    }
};


template <class Epi, class Sched, bool ALIGN_EPI = false, bool SP2 = false>
__device__ __forceinline__ void gemm_phase(PG8_LAS unsigned char* lds, const Gemm g, const Sched& S, const Epi& E) {
    int tid = threadIdx.x; asm volatile("" : "+v"(tid));
    const int wid = __builtin_amdgcn_readfirstlane(tid >> 6), lane = tid & 63, wr = wid >> 2, wc = wid & 3, fr = lane & 15, fq = lane >> 4;
    int K = g.K; asm volatile("" : "+s"(K)); const int nt = K / BK;
    unsigned voffA[2], voffB[2];
#pragma unroll
    for (int i = 0; i < 2; ++i) { int R, C; stage_rc(tid * 16 + i * 8192, R, C); const int Rb = Epi::PERM ? ((R & ~31) + perm32(R & 31)) : R;
        voffA[i] = (unsigned)(R * g.lda + C) * 2u; voffB[i] = (unsigned)(Rb * K + C) * 2u; }
    const size_t kstep = (size_t)(BK * 2);
    const size_t hstepB = (size_t)HALF * K * 2, hstepA = (size_t)HALF * g.lda * 2;
    const size_t tstepB = 2 * hstepB, tstepA = 2 * hstepA;
    const unsigned ldsw = (unsigned)wid * 1024u;
    const int aoff = lds_byte(wr * 64 + fr, fq * 8), boff = lds_byte(wc * 32 + fr, fq * 8);
#define PG8_SA(b, h) (((b) * 2 + (h)) * HTB)
#define PG8_SB(b, h) ((4 + (b) * 2 + (h)) * HTB)
#define PG8_STAGE(bufoff, gbase, voff) do { _Pragma("unroll") for (int _i = 0; _i < 2; ++_i) \
        __builtin_amdgcn_global_load_lds((const unsigned*)((const char*)(gbase) + (voff)[_i]), (PG8_LAS unsigned*)(lds + (bufoff) + ldsw + _i * 8192), 16, 0, 0); } while (0)
#define PG8_LDA(dst, b, h) do { _Pragma("unroll") for (int m = 0; m < 4; ++m) _Pragma("unroll") for (int k = 0; k < 2; ++k) dst[m][k] = *(const PG8_LAS bf16x8*)(lds + PG8_SA(b, h) + aoff + m * 2048 + k * 1024); } while (0)
#define PG8_LDB(dst, b, h) do { _Pragma("unroll") for (int n = 0; n < 2; ++n) _Pragma("unroll") for (int k = 0; k < 2; ++k) dst[n][k] = *(const PG8_LAS bf16x8*)(lds + PG8_SB(b, h) + boff + n * 2048 + k * 1024); } while (0)
#define PG8_MMA(ai, bj, At, Bt) do { __builtin_amdgcn_s_setprio(1); _Pragma("unroll") for (int m = 0; m < 4; ++m) _Pragma("unroll") for (int n = 0; n < 2; ++n) _Pragma("unroll") for (int k = 0; k < 2; ++k) \
        acc[ai][bj][m][n] = __builtin_amdgcn_mfma_f32_16x16x32_bf16(Bt[n][k], At[m][k], acc[ai][bj][m][n], 0, 0, 0); __builtin_amdgcn_s_setprio(0); } while (0)
#define PG8_WAIT_V(n) asm volatile("s_waitcnt vmcnt(" #n ")" ::: "memory")
#define PG8_WAIT_L(n) asm volatile("s_waitcnt lgkmcnt(" #n ")" ::: "memory")
#define PG8_BAR __builtin_amdgcn_s_barrier()
#define PG8_SCHED __builtin_amdgcn_sched_barrier(0)
    Unit cur, nxt; int ui = 0;
    if (!S.next(0, cur)) return;
    f32x4 acc[2][2][4][2];
#pragma unroll
    for (int a = 0; a < 2; ++a)
#pragma unroll
        for (int b = 0; b < 2; ++b)
#pragma unroll
            for (int m = 0; m < 4; ++m)
#pragma unroll
                for (int n = 0; n < 2; ++n) acc[a][b][m][n] = (f32x4){0.f, 0.f, 0.f, 0.f};
    bf16x8 At[4][2], B0[2][2], B1[2][2];
    const char* cA = (const char*)g.A + (size_t)cur.pm * tstepA + (size_t)(cur.pn >> g.apn_shift) * g.apn_bytes; const char* cB = (const char*)g.Bt + (size_t)cur.pn * tstepB;
    S.a_ready(cur);
    if constexpr (SP2) {
        PG8_STAGE(PG8_SB(0, 0), cB, voffB); PG8_STAGE(PG8_SB(0, 1), cB + hstepB, voffB); PG8_STAGE(PG8_SA(0, 0), cA, voffA); PG8_STAGE(PG8_SA(0, 1), cA + hstepA, voffA);
        if (wr == 1) PG8_BAR;
        PG8_WAIT_V(2); PG8_BAR;
        PG8_STAGE(PG8_SB(1, 0), cB + kstep, voffB); PG8_STAGE(PG8_SA(1, 0), cA + kstep, voffA); PG8_STAGE(PG8_SB(1, 1), cB + hstepB + kstep, voffB);
        PG8_WAIT_V(6); PG8_BAR;
    } else {
        PG8_STAGE(PG8_SB(0, 0), cB, voffB); PG8_STAGE(PG8_SA(0, 0), cA, voffA); PG8_STAGE(PG8_SB(0, 1), cB + hstepB, voffB); PG8_STAGE(PG8_SA(0, 1), cA + hstepA, voffA);
        if (wr == 1) PG8_BAR;
        PG8_WAIT_V(4); PG8_BAR;
        PG8_STAGE(PG8_SB(1, 0), cB + kstep, voffB); PG8_STAGE(PG8_SA(1, 0), cA + kstep, voffA); PG8_STAGE(PG8_SB(1, 1), cB + hstepB + kstep, voffB);
        PG8_WAIT_V(6); PG8_BAR;
    }
    for (;;) {
        const bool has_next = S.next(ui + 1, nxt);
        const char* nA = has_next ? (const char*)g.A + (size_t)nxt.pm * tstepA + (size_t)(nxt.pn >> g.apn_shift) * g.apn_bytes : cA; const char* nB = has_next ? (const char*)g.Bt + (size_t)nxt.pn * tstepB : cB;
        for (int t = 0; t < nt; t += 2) {
            const bool last = (t == nt - 2);
            const char* a1 = cA + (size_t)(t + 1) * kstep;
            const char* a2 = last ? nA : cA + (size_t)(t + 2) * kstep; const char* b2 = last ? nB : cB + (size_t)(t + 2) * kstep;
            const char* a3 = a2 + kstep; const char* b3 = b2 + kstep;
            if (last && has_next) S.a_ready(nxt);
            if constexpr (SP2) {
            PG8_LDB(B0, 0, 0); PG8_LDB(B1, 0, 1); PG8_SCHED; PG8_LDA(At, 0, 0); PG8_STAGE(PG8_SA(1, 1), a1 + hstepA, voffA);
            PG8_WAIT_V(8); PG8_WAIT_L(0); PG8_BAR; PG8_MMA(0, 0, At, B0); PG8_MMA(0, 1, At, B1); PG8_BAR; PG8_SCHED;
            PG8_LDA(At, 0, 1); PG8_STAGE(PG8_SB(0, 0), b2, voffB); PG8_STAGE(PG8_SB(0, 1), b2 + hstepB, voffB); PG8_STAGE(PG8_SA(0, 0), a2, voffA);
            PG8_WAIT_V(8); PG8_WAIT_L(0); PG8_BAR; PG8_MMA(1, 0, At, B0); PG8_MMA(1, 1, At, B1); PG8_BAR; PG8_SCHED;
            PG8_LDB(B0, 1, 0); PG8_LDB(B1, 1, 1); PG8_SCHED; PG8_LDA(At, 1, 0); PG8_STAGE(PG8_SA(0, 1), a2 + hstepA, voffA);
            PG8_WAIT_V(8); PG8_WAIT_L(0); PG8_BAR; PG8_MMA(0, 0, At, B0); PG8_MMA(0, 1, At, B1); PG8_BAR; PG8_SCHED;
            PG8_LDA(At, 1, 1); PG8_STAGE(PG8_SB(1, 0), b3, voffB); PG8_STAGE(PG8_SB(1, 1), b3 + hstepB, voffB); PG8_STAGE(PG8_SA(1, 0), a3, voffA);
            PG8_WAIT_V(8); PG8_WAIT_L(0); PG8_BAR; PG8_MMA(1, 0, At, B0); PG8_MMA(1, 1, At, B1); PG8_BAR; PG8_SCHED;
            } else {
            PG8_LDB(B0, 0, 0); PG8_SCHED; PG8_LDA(At, 0, 0); PG8_STAGE(PG8_SA(1, 1), a1 + hstepA, voffA);
            PG8_WAIT_L(8); PG8_BAR; PG8_WAIT_L(0); PG8_MMA(0, 0, At, B0); PG8_BAR; PG8_SCHED;
            PG8_LDB(B1, 0, 1); PG8_STAGE(PG8_SB(0, 0), b2, voffB);
            PG8_BAR; PG8_WAIT_L(0); PG8_MMA(0, 1, At, B1); PG8_BAR;
            PG8_LDA(At, 0, 1); PG8_STAGE(PG8_SA(0, 0), a2, voffA);
            PG8_BAR; PG8_WAIT_L(0); PG8_MMA(1, 0, At, B0); PG8_BAR; PG8_SCHED;
            PG8_STAGE(PG8_SB(0, 1), b2 + hstepB, voffB);
            PG8_WAIT_V(6); PG8_BAR; PG8_MMA(1, 1, At, B1); PG8_BAR;
            PG8_LDB(B0, 1, 0); PG8_SCHED; PG8_LDA(At, 1, 0); PG8_STAGE(PG8_SA(0, 1), a2 + hstepA, voffA);
            PG8_WAIT_L(8); PG8_BAR; PG8_WAIT_L(0); PG8_MMA(0, 0, At, B0); PG8_BAR; PG8_SCHED;
            PG8_LDB(B1, 1, 1); PG8_STAGE(PG8_SB(1, 0), b3, voffB);
            PG8_BAR; PG8_WAIT_L(0); PG8_MMA(0, 1, At, B1); PG8_BAR;
            PG8_LDA(At, 1, 1); PG8_STAGE(PG8_SA(1, 0), a3, voffA);
            PG8_BAR; PG8_WAIT_L(0); PG8_MMA(1, 0, At, B0); PG8_BAR; PG8_SCHED;
            PG8_STAGE(PG8_SB(1, 1), b3 + hstepB, voffB);
            PG8_WAIT_V(6); PG8_BAR; PG8_MMA(1, 1, At, B1); PG8_BAR;
            }
        }
        if constexpr (ALIGN_EPI) { if (wr == 0) PG8_BAR; }
        if constexpr (!Epi::AFTER_DRAIN) { E(acc, cur, wr, wc, fr, fq); S.done(cur); }
        if (!has_next) break;
#pragma unroll
        for (int a = 0; a < 2; ++a)
#pragma unroll
            for (int b = 0; b < 2; ++b)
#pragma unroll
                for (int m = 0; m < 4; ++m)
#pragma unroll
                    for (int n = 0; n < 2; ++n) acc[a][b][m][n] = (f32x4){0.f, 0.f, 0.f, 0.f};
        cur = nxt; cA = nA; cB = nB; ++ui;
        if constexpr (ALIGN_EPI) { if (wr == 1) PG8_BAR; }
    }
    PG8_WAIT_V(0);
    if constexpr (!ALIGN_EPI) { if (wr == 0) PG8_BAR; }
    PG8_BAR;
    if constexpr (Epi::AFTER_DRAIN) { E.fused(acc, cur, wr, wc, fr, fq, lds, wid, lane); S.done(cur); }
#undef PG8_SA
#undef PG8_SB
#undef PG8_STAGE
#undef PG8_LDA
#undef PG8_LDB
#undef PG8_MMA
#undef PG8_WAIT_V
#undef PG8_WAIT_L
#undef PG8_BAR
#undef PG8_SCHED
}
}

#define LAS __attribute__((address_space(3)))
typedef unsigned short bf16;
typedef pg8::f32x4 f32x4;
typedef pg8::u32x4 u32x4;
typedef pg8::u32x2 u32x2;
typedef float f32x2 __attribute__((ext_vector_type(2)));
typedef pg8::bf16x8 bf16x8;
using pg8::cvt_pk_bf16; using pg8::bf_lo; using pg8::bf_hi; using pg8::fsigmoid;

constexpr int M = 32768, D = 1024, SEQ = 2048, NB = 16, NHEAD = 8;
constexpr int ZCOLS = 6144;
constexpr size_t SLOT = (size_t)M * D * 2;
constexpr size_t WS_H = 0 * SLOT, WS_XA = 1 * SLOT, WS_GA = 2 * SLOT, WS_Q = 3 * SLOT, WS_F = 4 * SLOT, WS_I = 5 * SLOT, WS_GB = 6 * SLOT, WS_MISC = 7 * SLOT;
constexpr size_t MS_WIN = 0, MS_PA = (size_t)16 << 20, MS_PB = (size_t)18 << 20, MS_WO = (size_t)20 << 20, MS_GBT = (size_t)22 << 20, MS_SP8 = (size_t)23 << 20, MS_BAR = ((size_t)23 << 20) + 4096, MS_CNT = MS_BAR + 14336, MS_PART = (size_t)24 << 20, MS_END = ((size_t)24 << 20) + ((size_t)1 << 20);
constexpr size_t WS_NEED = WS_MISC + MS_END;
constexpr int LDS_BYTES = 144 * 1024;
constexpr float EPS = 1e-6f;
constexpr float L2E = 1.44269504089f;

__device__ __forceinline__ float wave_sum(float v) {
#pragma unroll
    for (int o = 1; o < 64; o <<= 1) v += __shfl_xor(v, o);
    return v;
}
__device__ __forceinline__ float fsilu(float x) { return x * fsigmoid(x); }

__device__ __forceinline__ void p0_transpose_item(const float* W, int K, int N, bf16* WT, LAS float* scr, int item, int lane) {
    const int nblk = N / 32, kb = item / nblk, nb = item % nblk, k0 = 64 * kb, n0 = 32 * nb;
#pragma unroll 8
    for (int i = 0; i < 32; ++i) { const int kk = 2 * i + (lane >> 5); scr[kk * 33 + (lane & 31)] = W[(size_t)(k0 + kk) * N + n0 + (lane & 31)]; }
    asm volatile("s_waitcnt lgkmcnt(0)" ::: "memory");
    const int c = lane & 7;
#pragma unroll
    for (int j = 0; j < 4; ++j) { const int n = (lane >> 3) + 8 * j; const LAS float* s = scr + (8 * c) * 33 + n;
        u32x4 o; o.x = cvt_pk_bf16(s[0 * 33], s[1 * 33]); o.y = cvt_pk_bf16(s[2 * 33], s[3 * 33]); o.z = cvt_pk_bf16(s[4 * 33], s[5 * 33]); o.w = cvt_pk_bf16(s[6 * 33], s[7 * 33]);
        *(u32x4*)(WT + (size_t)(n0 + n) * K + k0 + 8 * c) = o; }
    asm volatile("s_waitcnt lgkmcnt(0)" ::: "memory");
}
template <int NR> __device__ __forceinline__ void rms_rows_to_bf16(const float* X, const float* g, bf16* O, int m0, int stride, int lane) {
    f32x4 v[NR][4]; float s[NR];
#pragma unroll
    for (int r = 0; r < NR; ++r) { const f32x4* xr = (const f32x4*)(X + (size_t)(m0 + r * stride) * D) + lane;
#pragma unroll
        for (int j = 0; j < 4; ++j) v[r][j] = __builtin_nontemporal_load(xr + 64 * j); }
    f32x4 gg[4];
#pragma unroll
    for (int j = 0; j < 4; ++j) gg[j] = ((const f32x4*)g + lane)[64 * j];
#pragma unroll
    for (int r = 0; r < NR; ++r) { float a = 0.f;
#pragma unroll
        for (int j = 0; j < 4; ++j) a += (v[r][j].x * v[r][j].x + v[r][j].y * v[r][j].y) + (v[r][j].z * v[r][j].z + v[r][j].w * v[r][j].w);
        s[r] = a; }
#pragma unroll
    for (int o = 1; o < 64; o <<= 1) {
#pragma unroll
        for (int r = 0; r < NR; ++r) s[r] += __shfl_xor(s[r], o); }
#pragma unroll
    for (int r = 0; r < NR; ++r) { const float rstd = 1.0f / sqrtf(s[r] * (1.f / D) + EPS); u32x2* o8 = (u32x2*)(O + (size_t)(m0 + r * stride) * D) + lane;
#pragma unroll
        for (int j = 0; j < 4; ++j) { u32x2 o; o.x = cvt_pk_bf16(v[r][j].x * rstd * gg[j].x, v[r][j].y * rstd * gg[j].y); o.y = cvt_pk_bf16(v[r][j].z * rstd * gg[j].z, v[r][j].w * rstd * gg[j].w); o8[64 * j] = o; } }
}
template <int NR> __device__ __forceinline__ void rms_rows_inplace(float* X, const float* g, int m0, int stride, int lane) {
    f32x4 v[NR][4]; float s[NR];
#pragma unroll
    for (int r = 0; r < NR; ++r) { const f32x4* xr = (const f32x4*)(X + (size_t)(m0 + r * stride) * D) + lane;
#pragma unroll
        for (int j = 0; j < 4; ++j) v[r][j] = xr[64 * j]; }
    f32x4 gg[4];
#pragma unroll
    for (int j = 0; j < 4; ++j) gg[j] = ((const f32x4*)g + lane)[64 * j];
#pragma unroll
    for (int r = 0; r < NR; ++r) { float a = 0.f;
#pragma unroll
        for (int j = 0; j < 4; ++j) a += (v[r][j].x * v[r][j].x + v[r][j].y * v[r][j].y) + (v[r][j].z * v[r][j].z + v[r][j].w * v[r][j].w);
        s[r] = a; }
#pragma unroll
    for (int o = 1; o < 64; o <<= 1) {
#pragma unroll
        for (int r = 0; r < NR; ++r) s[r] += __shfl_xor(s[r], o); }
#pragma unroll
    for (int r = 0; r < NR; ++r) { const float rstd = 1.0f / sqrtf(s[r] * (1.f / D) + EPS); f32x4* xr = (f32x4*)(X + (size_t)(m0 + r * stride) * D) + lane;
#pragma unroll
        for (int j = 0; j < 4; ++j) xr[64 * j] = (v[r][j] * rstd) * gg[j]; }
}

struct Params {
    const float *x, *w_in, *b_merge, *conv_w, *conv_b, *rg_wx, *rg_bx, *rg_wa, *rg_ba, *rg_lambda, *hg_lb, *hg_norm_g, *proj_a, *proj_b, *w_out, *norm_g, *final_g;
    float* out; unsigned char* ws; unsigned* bar; int use_cg_sync; int pad;
};

__device__ __forceinline__ void p0_prologue(const Params& P, LAS unsigned char* lds, int wave, int lane) {
    unsigned char* ms = P.ws + WS_MISC;
    LAS float* scr = (LAS float*)(lds + wave * 16384);
    const int G = gridDim.x, gw = blockIdx.x * 8 + wave, NGW = G * 8;
    constexpr int I_IN = (D / 64) * (8192 / 32), I_P = (D / 64) * (D / 32);
    for (int it = gw; it < I_IN + 3 * I_P; it += NGW) {
        int r = it;
        if (r < I_IN) { p0_transpose_item(P.w_in, D, 8192, (bf16*)(ms + MS_WIN), scr, r, lane); continue; } r -= I_IN;
        if (r < I_P) { p0_transpose_item(P.proj_a, D, D, (bf16*)(ms + MS_PA), scr, r, lane); continue; } r -= I_P;
        if (r < I_P) { p0_transpose_item(P.proj_b, D, D, (bf16*)(ms + MS_PB), scr, r, lane); continue; } r -= I_P;
        p0_transpose_item(P.w_out, D, D, (bf16*)(ms + MS_WO), scr, r, lane);
    }
    { bf16* GB = (bf16*)(ms + MS_GBT); const int gt = blockIdx.x * 512 + wave * 64 + lane, GT = G * 512;
      for (int e = gt; e < 2048 * 256; e += GT) { const int cl = e & 127, k = (e >> 7) & 255, gate = (e >> 15) & 1, blk = e >> 16;
          const int kin = k - 128 * (blk & 1); float v = 0.f;
          if (kin >= 0 && kin < 128) v = (gate ? P.rg_wa : P.rg_wx)[((size_t)blk * 128 + kin) * 128 + cl];
          GB[(size_t)(256 * blk + 128 * gate + cl) * 256 + k] = (bf16)(cvt_pk_bf16(v, 0.f) & 0xffffu); }
      float* sp8 = (float*)(ms + MS_SP8);
      for (int e = gt; e < D; e += GT) sp8[e] = 8.0f * log1pf(expf(-P.rg_lambda[e])); }
    bf16* H = (bf16*)(P.ws + WS_H);
    for (int m = gw; m < M; m += 4 * NGW) rms_rows_to_bf16<4>(P.x, P.norm_g, H, m, NGW, lane);
}

constexpr int HG_QIN = 0, HG_KIN = 17408, HG_QINT = 34816, HG_KST = 52224, HG_VT = 70656, HG_ATT = 89088, HG_ST = 98304, HG_TOT = 133120, HG_LF = 137216, HG_DEC = 137728, HG_SSQ = 138240;
__device__ __forceinline__ bf16x8 lds_frag(LAS unsigned char* p) { return *(const LAS bf16x8*)p; }

#define HG_PREP1(NXT_ROW)                                                                                                   \
    _Pragma("unroll") for (int tt = 0; tt < 8; ++tt) { _Pragma("unroll") for (int c = 0; c < 2; ++c) {                     \
        const float fp = c ? bf_hi(rf[tt]) : bf_lo(rf[tt]);                                                                 \
        { const float qv_ = c ? bf_hi(rq[tt]) : bf_lo(rq[tt]); qh[tt][c] = S1_SILU ? qv_ : fsilu(qv_) * 0.08838834764831845f; } vv[tt][c] = c ? bf_hi(ri[tt]) : bf_lo(ri[tt]); \
        const float sg = fsigmoid(fp), f = lb[c] + (1.0f - lb[c]) * sg;                                                     \
        kk[tt][c] = (1.0f - lb[c]) * (1.0f - sg); pf[tt][c] = tt ? f * pf[tt - 1][c] : f; } }                               \
    *(LAS f32x2*)(lds + HG_TOT + (w * 128 + d0) * 4) = (f32x2){pf[7][0], pf[7][1]};                                         \
    if (w == 4) *(LAS f32x2*)(lds + HG_LF + d0 * 4) = (f32x2){pf[0][0], pf[0][1]};                                          \
    if ((NXT_ROW) < row0 + SEQ) { _Pragma("unroll") for (int tt = 0; tt < 8; ++tt) { const size_t o = ((NXT_ROW) + w * 8 + tt) * D + colq; \
        rq[tt] = __builtin_nontemporal_load((const unsigned*)(Qs + o)); rf[tt] = __builtin_nontemporal_load((const unsigned*)(Fs + o)); ri[tt] = __builtin_nontemporal_load((const unsigned*)(Is + o)); } }
__device__ __forceinline__ void hgrn_item2(const Params& P, LAS unsigned char* lds, int b, int hd, int w, int l, bf16* YB) {
    const bf16* Qs = (const bf16*)(P.ws + WS_Q); const bf16* Fs = (const bf16*)(P.ws + WS_F); const bf16* Is = (const bf16*)(P.ws + WS_I); const bf16* GBs = (const bf16*)(P.ws + WS_GB);
    const int fr = l & 15, fq = l >> 4, ti = w >> 1, wh = w & 1, th = w >> 2, vq = w & 3;
    const int d0 = 2 * l;
    float lb[2];
#pragma unroll
    for (int c = 0; c < 2; ++c) { const float l0 = P.hg_lb[hd * 128 + d0 + c], l1 = P.hg_lb[D + hd * 128 + d0 + c]; lb[c] = 1.0f / (1.0f + expf(l1 - l0)); }
    f32x4 gn[2];
#pragma unroll
    for (int vv2 = 0; vv2 < 2; ++vv2) gn[vv2] = *(const f32x4*)(P.hg_norm_g + 16 * (2 * vq + vv2) + 4 * fq);
    f32x4 S[4][2];
#pragma unroll
    for (int i = 0; i < 4; ++i) { S[i][0] = (f32x4){0.f, 0.f, 0.f, 0.f}; S[i][1] = S[i][0]; }
    __syncthreads();
    for (int e = w * 64 + l; e < 34816 / 4; e += 512) ((LAS unsigned*)(lds + HG_ST))[e] = 0u;
    const size_t row0 = (size_t)b * SEQ;
    const int colq = hd * 128 + d0;
    unsigned rq[8], rf[8], ri[8];
#pragma unroll
    for (int tt = 0; tt < 8; ++tt) { const size_t o = (row0 + w * 8 + tt) * D + colq; rq[tt] = __builtin_nontemporal_load((const unsigned*)(Qs + o)); rf[tt] = __builtin_nontemporal_load((const unsigned*)(Fs + o)); ri[tt] = __builtin_nontemporal_load((const unsigned*)(Is + o)); }
    float qh[8][2], kk[8][2], pf[8][2], vv[8][2];
    HG_PREP1(row0 + 64)
    __syncthreads();
    for (int n = 0; n < 32; ++n) {
        const size_t crow = row0 + (size_t)n * 64;
        u32x2 gbv[2][2];
#pragma unroll
        for (int tt2 = 0; tt2 < 2; ++tt2)
#pragma unroll
            for (int vv2 = 0; vv2 < 2; ++vv2) gbv[tt2][vv2] = __builtin_nontemporal_load((const u32x2*)(GBs + (crow + 16 * (2 * th + tt2) + fr) * D + hd * 128 + 16 * (2 * vq + vv2) + 4 * fq));
        { float off[2] = {1.f, 1.f}, pmid[2] = {1.f, 1.f}, plast[2] = {1.f, 1.f};
#pragma unroll
          for (int g = 0; g < 8; ++g) { const f32x2 t2 = *(const LAS f32x2*)(lds + HG_TOT + (g * 128 + d0) * 4);
              if (g < w) { off[0] *= t2.x; off[1] *= t2.y; }
              if (g < 4) { pmid[0] *= t2.x; pmid[1] *= t2.y; }
              plast[0] *= t2.x; plast[1] *= t2.y; }
          { const f32x2 t2 = *(const LAS f32x2*)(lds + HG_LF + d0 * 4); pmid[0] *= t2.x; pmid[1] *= t2.y; }
          float rpmid[2];
#pragma unroll
          for (int c = 0; c < 2; ++c) rpmid[c] = __builtin_amdgcn_rcpf(pmid[c]);
          if (w == 0) *(LAS f32x2*)(lds + HG_DEC + d0 * 4) = (f32x2){plast[0], plast[1]};
          float kst[8][2];
#pragma unroll
          for (int tt = 0; tt < 8; ++tt) {
              float qin[2], kin[2], qint[2];
#pragma unroll
              for (int c = 0; c < 2; ++c) {
                  const float Pt = off[c] * pf[tt][c], rP = __builtin_amdgcn_rcpf(Pt);
                  qint[c] = qh[tt][c] * Pt; qin[c] = qint[c] * rpmid[c];
                  const float kr = kk[tt][c] * rP; kin[c] = kr * pmid[c]; kst[tt][c] = kr * plast[c];
              }
              const int t = w * 8 + tt;
              *(LAS unsigned*)(lds + HG_QIN + t * 272 + d0 * 2) = cvt_pk_bf16(qin[0], qin[1]);
              *(LAS unsigned*)(lds + HG_KIN + t * 272 + d0 * 2) = cvt_pk_bf16(kin[0], kin[1]);
              *(LAS unsigned*)(lds + HG_QINT + t * 272 + d0 * 2) = cvt_pk_bf16(qint[0], qint[1]);
          }
#pragma unroll
          for (int c = 0; c < 2; ++c) {
              u32x4 pk, pv;
              pk.x = cvt_pk_bf16(kst[0][c], kst[1][c]); pk.y = cvt_pk_bf16(kst[2][c], kst[3][c]); pk.z = cvt_pk_bf16(kst[4][c], kst[5][c]); pk.w = cvt_pk_bf16(kst[6][c], kst[7][c]);
              pv.x = cvt_pk_bf16(vv[0][c], vv[1][c]); pv.y = cvt_pk_bf16(vv[2][c], vv[3][c]); pv.z = cvt_pk_bf16(vv[4][c], vv[5][c]); pv.w = cvt_pk_bf16(vv[6][c], vv[7][c]);
              *(LAS u32x4*)(lds + HG_KST + (d0 + c) * 144 + w * 16) = pk;
              *(LAS u32x4*)(lds + HG_VT + (d0 + c) * 144 + w * 16) = pv;
          } }
        __syncthreads();
        if (n < 31) { HG_PREP1(crow + 128) }
        { bf16x8 yq[4];
#pragma unroll
          for (int ks = 0; ks < 4; ++ks) yq[ks] = lds_frag(lds + HG_QIN + (16 * ti + fr) * 272 + ks * 64 + fq * 16);
#pragma unroll
          for (int sjj = 0; sjj < 2; ++sjj) { const int sj = wh * 2 + sjj;
              f32x4 a = (f32x4){0.f, 0.f, 0.f, 0.f};
#pragma unroll
              for (int ks = 0; ks < 4; ++ks) a = __builtin_amdgcn_mfma_f32_16x16x32_bf16(lds_frag(lds + HG_KIN + (16 * sj + fr) * 272 + ks * 64 + fq * 16), yq[ks], a, 0, 0, 0);
              const int t = 16 * ti + fr, s0 = 16 * sj + 4 * fq;
#pragma unroll
              for (int j = 0; j < 4; ++j) a[j] = (s0 + j <= t) ? a[j] : 0.f;
              u32x2 pk; pk.x = cvt_pk_bf16(a[0], a[1]); pk.y = cvt_pk_bf16(a[2], a[3]);
              *(LAS u32x2*)(lds + HG_ATT + (16 * ti + fr) * 144 + (16 * sj + 4 * fq) * 2) = pk; } }
        f32x4 oa[2][2];
#pragma unroll
        for (int i = 0; i < 2; ++i) { oa[i][0] = (f32x4){0.f, 0.f, 0.f, 0.f}; oa[i][1] = oa[i][0]; }
#pragma unroll
        for (int ks = 0; ks < 4; ++ks) {
            bf16x8 yf[2], xf[2];
#pragma unroll
            for (int i = 0; i < 2; ++i) { yf[i] = lds_frag(lds + HG_QINT + (16 * (2 * th + i) + fr) * 272 + ks * 64 + fq * 16); xf[i] = lds_frag(lds + HG_ST + (16 * (2 * vq + i) + fr) * 272 + ks * 64 + fq * 16); }
#pragma unroll
            for (int tt2 = 0; tt2 < 2; ++tt2)
#pragma unroll
                for (int vv2 = 0; vv2 < 2; ++vv2) oa[tt2][vv2] = __builtin_amdgcn_mfma_f32_16x16x32_bf16(xf[vv2], yf[tt2], oa[tt2][vv2], 0, 0, 0);
        }
        __syncthreads();
#pragma unroll
        for (int ks = 0; ks < 2; ++ks) {
            bf16x8 yf[2], xf[2];
#pragma unroll
            for (int i = 0; i < 2; ++i) { yf[i] = lds_frag(lds + HG_ATT + (16 * (2 * th + i) + fr) * 144 + ks * 64 + fq * 16); xf[i] = lds_frag(lds + HG_VT + (16 * (2 * vq + i) + fr) * 144 + ks * 64 + fq * 16); }
#pragma unroll
            for (int tt2 = 0; tt2 < 2; ++tt2)
#pragma unroll
                for (int vv2 = 0; vv2 < 2; ++vv2) oa[tt2][vv2] = __builtin_amdgcn_mfma_f32_16x16x32_bf16(xf[vv2], yf[tt2], oa[tt2][vv2], 0, 0, 0);
        }
#pragma unroll
        for (int tt2 = 0; tt2 < 2; ++tt2) { float ss = 0.f;
#pragma unroll
            for (int vv2 = 0; vv2 < 2; ++vv2) ss += (oa[tt2][vv2][0] * oa[tt2][vv2][0] + oa[tt2][vv2][1] * oa[tt2][vv2][1]) + (oa[tt2][vv2][2] * oa[tt2][vv2][2] + oa[tt2][vv2][3] * oa[tt2][vv2][3]);
            ss += __shfl_xor(ss, 16); ss += __shfl_xor(ss, 32);
            if (fq == 0) *(LAS float*)(lds + HG_SSQ + (vq * 64 + 16 * (2 * th + tt2) + fr) * 4) = ss; }
#pragma unroll
        for (int dd = 0; dd < 4; ++dd) { const f32x4 dec = *(const LAS f32x4*)(lds + HG_DEC + (16 * (4 * th + dd) + 4 * fq) * 4);
            S[dd][0] = S[dd][0] * dec; S[dd][1] = S[dd][1] * dec; }
#pragma unroll
        for (int ks = 0; ks < 2; ++ks) {
            bf16x8 yv[2];
#pragma unroll
            for (int i = 0; i < 2; ++i) yv[i] = lds_frag(lds + HG_VT + (16 * (2 * vq + i) + fr) * 144 + ks * 64 + fq * 16);
#pragma unroll
            for (int dd = 0; dd < 4; ++dd) { const bf16x8 xk = lds_frag(lds + HG_KST + (16 * (4 * th + dd) + fr) * 144 + ks * 64 + fq * 16);
                S[dd][0] = __builtin_amdgcn_mfma_f32_16x16x32_bf16(xk, yv[0], S[dd][0], 0, 0, 0);
                S[dd][1] = __builtin_amdgcn_mfma_f32_16x16x32_bf16(xk, yv[1], S[dd][1], 0, 0, 0); }
        }
#pragma unroll
        for (int dd = 0; dd < 4; ++dd)
#pragma unroll
            for (int vv2 = 0; vv2 < 2; ++vv2) { const f32x4 sv = S[dd][vv2]; u32x2 pk; pk.x = cvt_pk_bf16(sv[0], sv[1]); pk.y = cvt_pk_bf16(sv[2], sv[3]);
                *(LAS u32x2*)(lds + HG_ST + (16 * (2 * vq + vv2) + fr) * 272 + (16 * (4 * th + dd) + 4 * fq) * 2) = pk; }
        __syncthreads();
#pragma unroll
        for (int tt2 = 0; tt2 < 2; ++tt2) { const int t = 16 * (2 * th + tt2) + fr;
            const float tot = (*(const LAS float*)(lds + HG_SSQ + t * 4) + *(const LAS float*)(lds + HG_SSQ + (64 + t) * 4)) + (*(const LAS float*)(lds + HG_SSQ + (128 + t) * 4) + *(const LAS float*)(lds + HG_SSQ + (192 + t) * 4));
            const float rstd = 1.0f / sqrtf(tot * (1.f / 128.f) + EPS);
#pragma unroll
            for (int vv2 = 0; vv2 < 2; ++vv2) {
                const size_t o = (crow + t) * D + hd * 128 + 16 * (2 * vq + vv2) + 4 * fq;
                const u32x2 g2 = gbv[tt2][vv2]; const f32x4 ov = oa[tt2][vv2];
                float g0 = bf_lo(g2.x), g1 = bf_hi(g2.x), g2f = bf_lo(g2.y), g3 = bf_hi(g2.y);
                if (!S1_SILU) { g0 = fsilu(g0); g1 = fsilu(g1); g2f = fsilu(g2f); g3 = fsilu(g3); }
                u32x2 pk; pk.x = cvt_pk_bf16(ov[0] * rstd * gn[vv2][0] * g0, ov[1] * rstd * gn[vv2][1] * g1);
                pk.y = cvt_pk_bf16(ov[2] * rstd * gn[vv2][2] * g2f, ov[3] * rstd * gn[vv2][3] * g3);
                *(u32x2*)(YB + o) = pk; } }
    }
    __syncthreads();
}

constexpr int LR_XCS = 0, LR_XCT = 17408, LR_GAT = 35840, LR_YAS = 54272;
__device__ __forceinline__ void lru_item(const Params& P, LAS unsigned char* lds, int b, int blk, int w, int l, bf16* YA) {
    const bf16* XA = (const bf16*)(P.ws + WS_XA); const bf16* GA = (const bf16*)(P.ws + WS_GA);
    const bf16* GBT = (const bf16*)(P.ws + WS_MISC + MS_GBT); const float* sp8 = (const float*)(P.ws + WS_MISC + MS_SP8);
    const int fr = l & 15, fq = l >> 4, c0 = 2 * l, chg = blk * 128;
    float cw[4][2], cb[2];
#pragma unroll
    for (int c = 0; c < 2; ++c) { cb[c] = P.conv_b[chg + c0 + c];
#pragma unroll
        for (int k = 0; k < 4; ++k) cw[k][c] = P.conv_w[k * D + chg + c0 + c]; }
    bf16x8 wfx[4], wfa[4];
#pragma unroll
    for (int ks = 0; ks < 4; ++ks) { const bf16* r = GBT + (size_t)(256 * blk + 16 * w + fr) * 256 + 128 * (blk & 1) + 32 * ks + 8 * fq;
        wfx[ks] = *(const bf16x8*)r; wfa[ks] = *(const bf16x8*)(r + 128 * 256); }
    const int ch = chg + 16 * w + fr;
    const float bxv = P.rg_bx[ch], bav = P.rg_ba[ch], spv = sp8[ch] * L2E;
    float hc = 0.f;
    const size_t row0 = (size_t)b * SEQ; const int col = chg + c0;
    unsigned rx[11], rg[8];
#pragma unroll
    for (int i = 0; i < 11; ++i) { const int tp = 8 * w + i - 3; rx[i] = (tp >= 0) ? *(const unsigned*)(XA + (row0 + tp) * D + col) : 0u; }
#pragma unroll
    for (int tt = 0; tt < 8; ++tt) rg[tt] = __builtin_nontemporal_load((const unsigned*)(GA + (row0 + 8 * w + tt) * D + col));
    __syncthreads();
    for (int n = 0; n < 32; ++n) {
        const size_t crow = row0 + (size_t)n * 64;
        float xc[8][2];
#pragma unroll
        for (int tt = 0; tt < 8; ++tt)
#pragma unroll
            for (int c = 0; c < 2; ++c) { float a = cb[c];
#pragma unroll
                for (int k = 0; k < 4; ++k) a += cw[k][c] * (c ? bf_hi(rx[tt + k]) : bf_lo(rx[tt + k]));
                xc[tt][c] = a; }
#pragma unroll
        for (int tt = 0; tt < 8; ++tt) *(LAS unsigned*)(lds + LR_XCS + (8 * w + tt) * 272 + c0 * 2) = cvt_pk_bf16(xc[tt][0], xc[tt][1]);
#pragma unroll
        for (int c = 0; c < 2; ++c) {
            u32x4 px, pg;
            px.x = cvt_pk_bf16(xc[0][c], xc[1][c]); px.y = cvt_pk_bf16(xc[2][c], xc[3][c]); px.z = cvt_pk_bf16(xc[4][c], xc[5][c]); px.w = cvt_pk_bf16(xc[6][c], xc[7][c]);
            if (c == 0) { pg.x = (rg[0] & 0xffffu) | (rg[1] << 16); pg.y = (rg[2] & 0xffffu) | (rg[3] << 16); pg.z = (rg[4] & 0xffffu) | (rg[5] << 16); pg.w = (rg[6] & 0xffffu) | (rg[7] << 16); }
            else        { pg.x = (rg[0] >> 16) | (rg[1] & 0xffff0000u); pg.y = (rg[2] >> 16) | (rg[3] & 0xffff0000u); pg.z = (rg[4] >> 16) | (rg[5] & 0xffff0000u); pg.w = (rg[6] >> 16) | (rg[7] & 0xffff0000u); }
            *(LAS u32x4*)(lds + LR_XCT + (c0 + c) * 144 + w * 16) = px;
            *(LAS u32x4*)(lds + LR_GAT + (c0 + c) * 144 + w * 16) = pg;
        }
        if (n < 31) {
#pragma unroll
            for (int i = 0; i < 11; ++i) rx[i] = *(const unsigned*)(XA + (crow + 64 + 8 * w + i - 3) * D + col);
#pragma unroll
            for (int tt = 0; tt < 8; ++tt) rg[tt] = __builtin_nontemporal_load((const unsigned*)(GA + (crow + 64 + 8 * w + tt) * D + col));
        }
        __syncthreads();
        f32x4 ax[4], aa[4];
#pragma unroll
        for (int tj = 0; tj < 4; ++tj) { ax[tj] = (f32x4){0.f, 0.f, 0.f, 0.f}; aa[tj] = ax[tj];
#pragma unroll
            for (int ks = 0; ks < 4; ++ks) { const bf16x8 xf = lds_frag(lds + LR_XCS + (16 * tj + fr) * 272 + ks * 64 + fq * 16);
                ax[tj] = __builtin_amdgcn_mfma_f32_16x16x32_bf16(xf, wfx[ks], ax[tj], 0, 0, 0);
                aa[tj] = __builtin_amdgcn_mfma_f32_16x16x32_bf16(xf, wfa[ks], aa[tj], 0, 0, 0); } }
#pragma unroll
        for (int tj = 0; tj < 4; ++tj) {
            const u32x2 xp = *(const LAS u32x2*)(lds + LR_XCT + (16 * w + fr) * 144 + (16 * tj + 4 * fq) * 2);
            const u32x2 gp = *(const LAS u32x2*)(lds + LR_GAT + (16 * w + fr) * 144 + (16 * tj + 4 * fq) * 2);
            const float xv[4] = {bf_lo(xp.x), bf_hi(xp.x), bf_lo(xp.y), bf_hi(xp.y)}, gv[4] = {bf_lo(gp.x), bf_hi(gp.x), bf_lo(gp.y), bf_hi(gp.y)};
            float hl[4], Ac[4];
#pragma unroll
            for (int j = 0; j < 4; ++j) {
                const float gi = fsigmoid(ax[tj][j] + bxv), gr = fsigmoid(aa[tj][j] + bav);
                const float a = __builtin_amdgcn_exp2f(-gr * spv);
                const float u = __builtin_amdgcn_sqrtf(fmaxf(1.0f - a * a, 0.f)) * gi * xv[j];
                hl[j] = j ? a * hl[j - 1] + u : u; Ac[j] = j ? a * Ac[j - 1] : a;
            }
            float Ag = Ac[3], Hg = hl[3];
            { const float A1 = __shfl_up(Ag, 16), H1 = __shfl_up(Hg, 16); if (fq >= 1) { Hg = Ag * H1 + Hg; Ag = Ag * A1; } }
            { const float A2 = __shfl_up(Ag, 32), H2 = __shfl_up(Hg, 32); if (fq >= 2) { Hg = Ag * H2 + Hg; Ag = Ag * A2; } }
            float Ae = __shfl_up(Ag, 16), He = __shfl_up(Hg, 16); if (fq == 0) { Ae = 1.f; He = 0.f; }
            const float At = __shfl(Ag, 48 + fr), Ht = __shfl(Hg, 48 + fr);
            const float hstart = Ae * hc + He;
#pragma unroll
            for (int j = 0; j < 4; ++j) { const float y = (hl[j] + Ac[j] * hstart) * fsilu(gv[j]);
                *(LAS unsigned short*)(lds + LR_YAS + (16 * tj + 4 * fq + j) * 272 + (16 * w + fr) * 2) = (unsigned short)(cvt_pk_bf16(y, 0.f) & 0xffffu); }
            hc = At * hc + Ht;
        }
        asm volatile("s_waitcnt vmcnt(0)" ::: "memory");
        __syncthreads();
#pragma unroll
        for (int tt = 0; tt < 8; ++tt) *(unsigned*)(YA + (crow + 8 * w + tt) * D + col) = *(const LAS unsigned*)(lds + LR_YAS + (8 * w + tt) * 272 + c0 * 2);
    }
    __syncthreads();
}

#define XB_TMO      128
#define XB_XCNT(j)  (256  + 64 * (j))
#define XB_XSUB(j)  (1280 + 64 * (j))
#define XB_XGEN(j)  (2304 + 64 * (j))
#define XB_TOP      3328
#define XB_TOPGEN   3392
#define XCD_BAR_WORDS 3456
#define XB_SPIN_CAP (1u << 18)

__device__ __forceinline__ unsigned xb_ld(unsigned* p)              { return __hip_atomic_load(p, __ATOMIC_RELAXED, __HIP_MEMORY_SCOPE_AGENT); }
__device__ __forceinline__ unsigned xb_add(unsigned* p, unsigned v) { return __hip_atomic_fetch_add(p, v, __ATOMIC_RELAXED, __HIP_MEMORY_SCOPE_AGENT); }
__device__ __forceinline__ unsigned xb_xcc_id() { return (unsigned)__builtin_amdgcn_s_getreg((3 << 11) | 20) & 0xFu; }
#define XB_SPIN(cond, bar) do { unsigned _sp = 0; while (cond) { __builtin_amdgcn_s_sleep(1); \
    if ((++_sp & 255u) == 0u) { if (xb_ld(&(bar)[XB_TMO])) break; if (_sp > XB_SPIN_CAP) { atomicAdd(&(bar)[XB_TMO], 1u); break; } } } } while (0)

struct XcdBarrier {
    unsigned* bar; unsigned x;
    volatile LAS unsigned* st;
};

__device__ __forceinline__ XcdBarrier xcd_barrier_post(unsigned* bar, volatile LAS unsigned* st) {
    XcdBarrier b; b.bar = bar; b.x = xb_xcc_id(); b.st = st;
    if (threadIdx.x == 0) (void)xb_add(&bar[XB_XCNT(b.x)], 1u);
    return b;
}
__device__ __forceinline__ void xcd_barrier_complete(unsigned* bar, unsigned x, unsigned& nloc, unsigned& nx) {
    const unsigned G = gridDim.x * gridDim.y * gridDim.z;
    unsigned sum, cnt, mine, sp = 0u;
    for (;;) {
        sum = 0u; cnt = 0u; mine = 0u;
#pragma unroll
        for (unsigned j = 0; j < 16; ++j) { const unsigned c = xb_ld(&bar[XB_XCNT(j)]); sum += c; cnt += (c > 0u) ? 1u : 0u; mine = (j == x) ? c : mine; }
        if (sum == G) break;
        __builtin_amdgcn_s_sleep(1);
        if ((++sp & 255u) == 0u) { if (xb_ld(&bar[XB_TMO])) break; if (sp > XB_SPIN_CAP) { atomicAdd(&bar[XB_TMO], 1u); break; } }
    }
    nloc = mine > 0u ? mine : 1u; nx = cnt > 0u ? cnt : 1u;
}

__device__ __forceinline__ void xcd_barrier(const XcdBarrier& b) {
    asm volatile("s_waitcnt vmcnt(0)" ::: "memory");
    __syncthreads();
    if (threadIdx.x == 0) {
        unsigned* bar = b.bar;
        __builtin_amdgcn_s_waitcnt(0);
        unsigned nloc = b.st[0], nx = b.st[1];
        if (nloc == 0u) { xcd_barrier_complete(bar, b.x, nloc, nx); b.st[0] = nloc; b.st[1] = nx; }
        const unsigned old = xb_add(&bar[XB_XSUB(b.x)], 1u);
        const unsigned gen = old / nloc;
        if (old + 1u == (gen + 1u) * nloc) {
            __builtin_amdgcn_fence(__ATOMIC_RELEASE, "agent");
            asm volatile("s_waitcnt vmcnt(0)" ::: "memory");
            const unsigned og = xb_add(&bar[XB_TOP], 1u);
            const unsigned tg = og / nx;
            if (og + 1u == (tg + 1u) * nx) xb_add(&bar[XB_TOPGEN], 1u);
            else XB_SPIN(xb_ld(&bar[XB_TOPGEN]) == tg, bar);
            __builtin_amdgcn_fence(__ATOMIC_ACQUIRE, "agent");
            xb_add(&bar[XB_XGEN(b.x)], 1u);
            asm volatile("s_waitcnt vmcnt(0)" ::: "memory");
        } else {
            XB_SPIN(xb_ld(&bar[XB_XGEN(b.x)]) == gen, bar);
            __builtin_amdgcn_fence(__ATOMIC_ACQUIRE, "agent");
            asm volatile("s_waitcnt vmcnt(0)" ::: "memory");
        }
    }
    __syncthreads();
}


constexpr int P6A_LRU_TILES = 3;
__global__ void __launch_bounds__(512, 2) hawk_hgrn2_fwd(Params P) {
    extern __shared__ __attribute__((aligned(16))) unsigned char lds_raw[];
    LAS unsigned char* lds = (LAS unsigned char*)lds_raw;
    cg::grid_group grid = cg::this_grid();
#define GRID_SYNC() xcd_barrier(xbar_)
#define PHASE_IDS() int tid = threadIdx.x; asm volatile("" : "+v"(tid)); const int lane = tid & 63, wave = __builtin_amdgcn_readfirstlane(tid >> 6); (void)lane; (void)wave
    const int G = gridDim.x;
    volatile LAS unsigned* xst_ = (volatile LAS unsigned*)(lds + (LDS_BYTES - 64));
    if (threadIdx.x < 16) xst_[threadIdx.x] = 0u;
    __syncthreads();
    const XcdBarrier xbar_ = xcd_barrier_post(P.bar, xst_);
    unsigned char* ws = P.ws; unsigned char* ms = ws + WS_MISC;
    bf16* const dH = (bf16*)(ws + WS_H); bf16* const dXA = (bf16*)(ws + WS_XA); bf16* const dGA = (bf16*)(ws + WS_GA); bf16* const dQ = (bf16*)(ws + WS_Q);
    bf16* const dF = (bf16*)(ws + WS_F); bf16* const dI = (bf16*)(ws + WS_I);
    bf16* const dGMA0 = (bf16*)P.out; bf16* const dGMB0 = (bf16*)P.out + (size_t)M * D;
    const bf16* WinT = (const bf16*)(ms + MS_WIN);

    if (P.use_cg_sync) grid.sync();
    { PHASE_IDS(); p0_prologue(P, lds, wave, lane); }
    GRID_SYNC();
    { pg8::Gemm g{dH, WinT, M, 8192, D, D, 0, 0};
      pg8::EpiBf16<2> E{dXA, (size_t)M * D, nullptr, P.b_merge, dGMA0, dGMB0};
      { pg8::StaticOrder S; S.init(M, 8192, G, (int)blockIdx.x); pg8::gemm_phase<pg8::EpiBf16<2>, pg8::StaticOrder, true, true>(lds, g, S, E); }
    }
    GRID_SYNC();
    { const int nh = G / 2;
      PHASE_IDS();
      if ((int)blockIdx.x < nh) {
        for (int it = blockIdx.x; it < NB * NHEAD; it += nh) hgrn_item2(P, lds, it >> 3, it & 7, wave, lane, dQ);
        { __syncthreads();
          if (threadIdx.x == 0) { unsigned* hb = P.bar + 3840 + 16 * ((int)blockIdx.x >> 3); unsigned sp = 0;
              while (__hip_atomic_load(hb, __ATOMIC_RELAXED, __HIP_MEMORY_SCOPE_AGENT) < 8u && ++sp < (1u << 22)) __builtin_amdgcn_s_sleep(2);
              __builtin_amdgcn_fence(__ATOMIC_ACQUIRE, "agent"); asm volatile("s_waitcnt vmcnt(0)" ::: "memory"); }
          __syncthreads(); }
        { pg8::Gemm g{dXA, (const bf16*)(ms + MS_PA), M, D, D, D, 0, 0}; pg8::ColOrder S{(int)blockIdx.x, P6A_LRU_TILES, 4 - P6A_LRU_TILES};
          pg8::EpiGate<0> E{dGMA0, nullptr, dH, P.b_merge};
          pg8::gemm_phase<pg8::EpiGate<0>, pg8::ColOrder, true, true>(lds, g, S, E); } }
      else {
        for (int it = (int)blockIdx.x - nh; it < NB * 8; it += G - nh) lru_item(P, lds, it >> 3, it & 7, wave, lane, dXA);
        { asm volatile("s_waitcnt vmcnt(0) lgkmcnt(0)" ::: "memory"); __syncthreads();
          if (threadIdx.x == 0) { __builtin_amdgcn_fence(__ATOMIC_RELEASE, "agent"); asm volatile("s_waitcnt vmcnt(0)" ::: "memory");
              unsigned* hb = P.bar + 3840 + 16 * (((int)blockIdx.x - nh) >> 3);
              __hip_atomic_fetch_add(hb, 1u, __ATOMIC_RELAXED, __HIP_MEMORY_SCOPE_AGENT);
              unsigned sp = 0; while (__hip_atomic_load(hb, __ATOMIC_RELAXED, __HIP_MEMORY_SCOPE_AGENT) < 8u && ++sp < (1u << 22)) __builtin_amdgcn_s_sleep(2);
              __builtin_amdgcn_fence(__ATOMIC_ACQUIRE, "agent"); asm volatile("s_waitcnt vmcnt(0)" ::: "memory"); }
          __syncthreads(); }
        { pg8::Gemm g{dXA, (const bf16*)(ms + MS_PA), M, D, D, D, 0, 0}; pg8::ColOrder S{(int)blockIdx.x - nh, 0, P6A_LRU_TILES};
          pg8::EpiGate<0> E{dGMA0, nullptr, dH, P.b_merge};
          pg8::gemm_phase<pg8::EpiGate<0>, pg8::ColOrder, true, true>(lds, g, S, E); } } }
    GRID_SYNC();
    { pg8::Gemm g{dQ, (const bf16*)(ms + MS_PB), M, D, D, D, 0, 0}; pg8::PanelOrder S; S.init(M, G, (int)blockIdx.x);
      pg8::EpiGate<1> E{dGMB0, dH, dF, P.b_merge + D};
      pg8::gemm_phase<pg8::EpiGate<1>, pg8::PanelOrder, true, true>(lds, g, S, E); }
    GRID_SYNC();
    { pg8::Gemm g{dF, (const bf16*)(ms + MS_WO), M, D, D, D, 0, 0}; pg8::PanelOrder S; S.init(M, G, (int)blockIdx.x);
      pg8::EpiFinal E{P.x, P.out, P.final_g, (float*)(ms + MS_PART), (unsigned*)(ms + MS_CNT), lds + 131072};
      pg8::gemm_phase<pg8::EpiFinal, pg8::PanelOrder, true, true>(lds, g, S, E); }
}

extern "C" void kernel_launch(void* const* d_in, const int* in_sizes, int n_in, void* d_out, int out_size, void* d_ws, size_t ws_size, hipStream_t stream) {
    static int grid = 0;
    if (!grid) {
        if (n_in != 17 || in_sizes[0] != M * D || out_size != M * D || ws_size < WS_NEED) {
            fprintf(stderr, "kernel_launch: unexpected shapes: n_in %d in0 %d out %d ws %zu (need %zu); nothing launched\n", n_in, n_in > 0 ? in_sizes[0] : -1, out_size, ws_size, (size_t)WS_NEED); grid = -1; return; }
        int dev = 0, cus = 0, per_cu = 0;
        if (hipGetDevice(&dev) != hipSuccess || hipDeviceGetAttribute(&cus, hipDeviceAttributeMultiprocessorCount, dev) != hipSuccess) { grid = -1; return; }
        if (hipFuncSetAttribute((const void*)hawk_hgrn2_fwd, hipFuncAttributeMaxDynamicSharedMemorySize, LDS_BYTES) != hipSuccess) { fprintf(stderr, "kernel_launch: hipFuncSetAttribute failed\n"); grid = -1; return; }
        if (hipOccupancyMaxActiveBlocksPerMultiprocessor(&per_cu, (const void*)hawk_hgrn2_fwd, 512, LDS_BYTES) != hipSuccess || per_cu < 1) { fprintf(stderr, "kernel_launch: occupancy query says %d\n", per_cu); }
        if (cus < 256) { fprintf(stderr, "kernel_launch: this build needs 256 co-resident workgroups (one per CU); the device has %d CUs; nothing launched\n", cus); grid = -1; return; }
        grid = 256;
    }
    if (grid <= 0) return;
    Params p{};
    p.x = (const float*)d_in[0]; p.w_in = (const float*)d_in[1]; p.b_merge = (const float*)d_in[2]; p.conv_w = (const float*)d_in[3]; p.conv_b = (const float*)d_in[4];
    p.rg_wx = (const float*)d_in[5]; p.rg_bx = (const float*)d_in[6]; p.rg_wa = (const float*)d_in[7]; p.rg_ba = (const float*)d_in[8]; p.rg_lambda = (const float*)d_in[9];
    p.hg_lb = (const float*)d_in[10]; p.hg_norm_g = (const float*)d_in[11]; p.proj_a = (const float*)d_in[12]; p.proj_b = (const float*)d_in[13]; p.w_out = (const float*)d_in[14];
    p.norm_g = (const float*)d_in[15]; p.final_g = (const float*)d_in[16];
    p.out = (float*)d_out; p.ws = (unsigned char*)d_ws; p.bar = (unsigned*)((unsigned char*)d_ws + WS_MISC + MS_BAR); p.use_cg_sync = 0; p.pad = 0;
    if (hipMemsetAsync(p.bar, 0, 16384, stream) != hipSuccess) { fprintf(stderr, "kernel_launch: memset failed\n"); return; }
    void* args[] = {&p};
    hipError_t e = hipLaunchCooperativeKernel((const void*)hawk_hgrn2_fwd, dim3(grid), dim3(512), args, LDS_BYTES, stream);
    if (e != hipSuccess) fprintf(stderr, "kernel_launch: cooperative launch failed: %s (grid %d)\n", hipGetErrorString(e), grid);
}
```

```cpp
#include <hip/hip_runtime.h>
#include <hip/hip_cooperative_groups.h>
#include <cstdio>
#include <cstdint>
namespace cg = cooperative_groups;

#ifndef GATE_SIG_IN_S1
#define GATE_SIG_IN_S1 0
#endif
#ifndef S1_SILU
#define S1_SILU 0
#endif
namespace pg8 {
#define PG8_LAS __attribute__((address_space(3)))
typedef unsigned short bf16_t;
typedef short bf16x8 __attribute__((ext_vector_type(8)));
typedef float f32x4 __attribute__((ext_vector_type(4)));
typedef unsigned u32x4 __attribute__((ext_vector_type(4)));
typedef unsigned u32x2 __attribute__((ext_vector_type(2)));
constexpr int BM = 256, BK = 64, HALF = 128, HTB = HALF * BK * 2  , STAGE_BYTES = 8 * HTB, NXCD = 8, WGM = 8;

__host__ __device__ __forceinline__ int lds_byte(int r, int c) { const int st = (r >> 4) * 2 + (c >> 5), rr = r & 15, cc = c & 31, ob = rr * 64 + cc * 2; return st * 1024 + (ob ^ (((ob >> 9) & 1) << 5)); }
__host__ __device__ __forceinline__ void stage_rc(int b, int& R, int& C) { const int st = b / 1024, sb = b % 1024, swz = sb ^ (((sb >> 9) & 1) << 5); R = (st >> 1) * 16 + swz / 64; C = (st & 1) * 32 + (swz % 64) / 2; }
__host__ __device__ __forceinline__ int perm32(int rho) { const int n = rho >> 4, i = rho & 15; return 8 * (i >> 2) + 4 * n + (i & 3); }

struct Unit { int pm, pn; };
struct Gemm { const bf16_t* A; const bf16_t* Bt; int M, N, K, lda, apn_shift, apn_bytes; };

struct StaticOrder {
    int nM, nN, nwg, G, c;
    __host__ __device__ void init(int M, int N, int G_, int c_) { nM = M / BM; nN = N / BM; nwg = nM * nN; G = G_; c = c_; }
    __host__ __device__ bool next(int i, Unit& u) const {
        const long L = (long)i * G + c; if (L >= nwg) return false;
        int wgid = (int)L; { const int q = nwg / NXCD, r = nwg % NXCD, xcd = wgid % NXCD, off = wgid / NXCD; wgid = (xcd < r ? xcd * (q + 1) : r * (q + 1) + (xcd - r) * q) + off; }
        const int nig = WGM * nN, gid = wgid / nig, fm = gid * WGM, gsz = (nM - fm) < WGM ? (nM - fm) : WGM;
        u.pm = fm + ((wgid % nig) % gsz); u.pn = (wgid % nig) / gsz; return true;
    }
    __device__ __forceinline__ void a_ready(const Unit&) const {}
    __device__ __forceinline__ void done(const Unit&) const {}
};

typedef float f32x2_t __attribute__((ext_vector_type(2)));
typedef __bf16 bf16x2_t __attribute__((ext_vector_type(2)));
__device__ __forceinline__ unsigned cvt_pk_bf16(float lo, float hi) { const f32x2_t v = {lo, hi}; const bf16x2_t b = __builtin_convertvector(v, bf16x2_t); return __builtin_bit_cast(unsigned, b); }
struct ColOrder {
    int pm, pn0, npn;
    __host__ __device__ bool next(int i, Unit& u) const { if (i >= npn) return false; u.pm = pm; u.pn = pn0 + i; return true; }
    __device__ __forceinline__ void a_ready(const Unit&) const {}
    __device__ __forceinline__ void done(const Unit&) const {}
};
__device__ __forceinline__ float bf_lo(unsigned w) { return __builtin_bit_cast(float, w << 16); }
__device__ __forceinline__ float bf_hi(unsigned w) { return __builtin_bit_cast(float, w & 0xffff0000u); }
__device__ __forceinline__ float fsigmoid(float x) { return __builtin_amdgcn_rcpf(1.0f + __builtin_amdgcn_exp2f(-1.44269504089f * x)); }
__device__ __forceinline__ u32x4 pack8(f32x4 v0, f32x4 v1) { u32x4 w; w.x = cvt_pk_bf16(v0[0], v0[1]); w.y = cvt_pk_bf16(v0[2], v0[3]); w.z = cvt_pk_bf16(v1[0], v1[1]); w.w = cvt_pk_bf16(v1[2], v1[3]); return w; }
__device__ __forceinline__ void unpack8(u32x4 w, f32x4& v0, f32x4& v1) { v0 = (f32x4){bf_lo(w.x), bf_hi(w.x), bf_lo(w.y), bf_hi(w.y)}; v1 = (f32x4){bf_lo(w.z), bf_hi(w.z), bf_lo(w.w), bf_hi(w.w)}; }

template <int ACT> struct EpiBf16 {
    static constexpr bool PERM = true, AFTER_DRAIN = false;
    bf16_t* O; size_t split_stride; bf16_t* O1; const float* bias; bf16_t* O6; bf16_t* O7;
    __device__ __forceinline__ void operator()(const f32x4 (&acc)[2][2][4][2], const Unit& u, int, int, int, int) const {
        int t_ = threadIdx.x; asm volatile("" : "+v"(t_));
        const int wid_ = t_ >> 6, wr = wid_ >> 2, wc = wid_ & 3, fr = t_ & 15, fq = (t_ >> 4) & 3;
        const int row0 = u.pm * BM + wr * 64 + fr; int colt = u.pn * BM; const int t = colt >> 10; colt &= 1023;
        bf16_t* base = (t == 1 && O1) ? O1 : O + (size_t)t * split_stride;
        if (ACT == 2) { if (t == 6) base = O6; if (t == 7) base = O7; }
        const int col0 = colt + wc * 32 + 8 * fq, bcol0 = u.pn * BM + wc * 32 + 8 * fq - (ACT == 2 ? 6144 : 0);
        const bool has_bias = (ACT == 1) || (ACT == 2 && GATE_SIG_IN_S1 && t >= 6);
        f32x4 bv[2][2];
#pragma unroll
        for (int bj = 0; bj < 2; ++bj)
#pragma unroll
            for (int n = 0; n < 2; ++n) bv[bj][n] = has_bias ? *(const f32x4*)(bias + bcol0 + bj * HALF + 4 * n) : (f32x4){0.f, 0.f, 0.f, 0.f};
#pragma unroll
        for (int ai = 0; ai < 2; ++ai)
#pragma unroll
            for (int m = 0; m < 4; ++m) { bf16_t* rowp = base + (size_t)(row0 + ai * HALF + m * 16) * 1024 + col0;
#pragma unroll
                for (int bj = 0; bj < 2; ++bj) { f32x4 v0 = acc[ai][bj][m][0] + bv[bj][0], v1 = acc[ai][bj][m][1] + bv[bj][1];
                    if (ACT == 1) {
#pragma unroll
                        for (int i = 0; i < 4; ++i) { v0[i] = fsigmoid(v0[i]); v1[i] = fsigmoid(v1[i]); } }
                    if (ACT == 2) { if (GATE_SIG_IN_S1 && t >= 6) {
#pragma unroll
                        for (int i = 0; i < 4; ++i) { v0[i] = fsigmoid(v0[i]); v1[i] = fsigmoid(v1[i]); } }
                      if (S1_SILU && (t == 2 || t == 5)) { const float sc = (t == 2) ? 0.08838834764831845f : 1.0f;
#pragma unroll
                        for (int i = 0; i < 4; ++i) { v0[i] = v0[i] * fsigmoid(v0[i]) * sc; v1[i] = v1[i] * fsigmoid(v1[i]) * sc; } } }
                    if (ACT == 2) __builtin_nontemporal_store(pack8(v0, v1), (u32x4*)(rowp + bj * HALF));
                    else *(u32x4*)(rowp + bj * HALF) = pack8(v0, v1); } }
    }
};
template <int MODE> struct EpiGate {
    static constexpr bool PERM = true, AFTER_DRAIN = false;
    const bf16_t* G; const bf16_t* T; bf16_t* O; const float* gbias;
    __device__ __forceinline__ void operator()(const f32x4 (&acc)[2][2][4][2], const Unit& u, int, int, int, int) const {
        int t_ = threadIdx.x; asm volatile("" : "+v"(t_));
        const int wid_ = t_ >> 6, wr = wid_ >> 2, wc = wid_ & 3, fr = t_ & 15, fq = (t_ >> 4) & 3;
        const int row0 = u.pm * BM + wr * 64 + fr, col0 = u.pn * BM + wc * 32 + 8 * fq;
        f32x4 gb_[2][2];
#pragma unroll
        for (int bj = 0; bj < 2; ++bj)
#pragma unroll
            for (int n = 0; n < 2; ++n) gb_[bj][n] = GATE_SIG_IN_S1 ? (f32x4){0.f, 0.f, 0.f, 0.f} : *(const f32x4*)(gbias + col0 + bj * HALF + 4 * n);
#pragma unroll
        for (int ai = 0; ai < 2; ++ai)
#pragma unroll
            for (int m = 0; m < 4; ++m) { const size_t ro = (size_t)(row0 + ai * HALF + m * 16) * 1024 + col0;
#pragma unroll
                for (int bj = 0; bj < 2; ++bj) {
                    f32x4 g0, g1; unpack8(__builtin_nontemporal_load((const u32x4*)(G + ro + bj * HALF)), g0, g1);
                    if (!GATE_SIG_IN_S1) {
#pragma unroll
                        for (int i = 0; i < 4; ++i) { g0[i] = fsigmoid(g0[i] + gb_[bj][0][i]); g1[i] = fsigmoid(g1[i] + gb_[bj][1][i]); } }
                    f32x4 v0 = acc[ai][bj][m][0] * g0, v1 = acc[ai][bj][m][1] * g1;
                    if (MODE == 1) { f32x4 t0, t1; unpack8(__builtin_nontemporal_load((const u32x4*)(T + ro + bj * HALF)), t0, t1); v0 = v0 + t0; v1 = v1 + t1; }
                    *(u32x4*)(O + ro + bj * HALF) = pack8(v0, v1); } }
    }
};
struct EpiResid {
    static constexpr bool PERM = true, AFTER_DRAIN = false;
    const float* X; float* O;
    __device__ __forceinline__ void operator()(const f32x4 (&acc)[2][2][4][2], const Unit& u, int, int, int, int) const {
        int t_ = threadIdx.x; asm volatile("" : "+v"(t_));
        const int wid_ = t_ >> 6, wr = wid_ >> 2, wc = wid_ & 3, fr = t_ & 15, fq = (t_ >> 4) & 3;
        const int row0 = u.pm * BM + wr * 64 + fr, col0 = u.pn * BM + wc * 32 + 8 * fq;
#pragma unroll
        for (int ai = 0; ai < 2; ++ai)
#pragma unroll
            for (int m = 0; m < 4; ++m) { const size_t ro = (size_t)(row0 + ai * HALF + m * 16) * 1024 + col0;
#pragma unroll
                for (int bj = 0; bj < 2; ++bj) {
                    const f32x4 x0 = *(const f32x4*)(X + ro + bj * HALF), x1 = *(const f32x4*)(X + ro + bj * HALF + 4);
                    *(f32x4*)(O + ro + bj * HALF) = x0 + acc[ai][bj][m][0]; *(f32x4*)(O + ro + bj * HALF + 4) = x1 + acc[ai][bj][m][1]; } }
    }
};

struct PanelOrder {
    int nwg, G, c;
    __host__ __device__ void init(int M, int G_, int c_) { nwg = (M / BM) * 4; G = G_; c = c_; }
    __host__ __device__ bool next(int i, Unit& u) const { const long L = (long)i * G + c; if (L >= nwg) return false;
        if ((G & 31) != 0) { u.pm = (int)(L >> 2); u.pn = (int)(L & 3); return true; }
        const int x = c & 7, k = c >> 3; u.pn = k & 3; u.pm = i * (G >> 2) + (k >> 2) * 8 + x; return true; }
    __device__ __forceinline__ void a_ready(const Unit&) const {}
    __device__ __forceinline__ void done(const Unit&) const {}
};
struct EpiFinal {
    static constexpr bool PERM = true, AFTER_DRAIN = false;
    const float* X; float* O; const float* gain; float* part; unsigned* cnt; PG8_LAS unsigned char* scr;
    __device__ __forceinline__ void operator()(f32x4 (&acc)[2][2][4][2], const Unit& u, int, int, int, int) const {
        int t_ = threadIdx.x; asm volatile("" : "+v"(t_));
        const int wid_ = t_ >> 6, wr = wid_ >> 2, wc = wid_ & 3, fr = t_ & 15, fq = (t_ >> 4) & 3;
        const int row0 = u.pm * BM + wr * 64 + fr, col0 = u.pn * BM + wc * 32 + 8 * fq;
        PG8_LAS float* ssl = (PG8_LAS float*)scr; PG8_LAS float* rstd_l = (PG8_LAS float*)(scr + 4096);
#pragma unroll
        for (int ai = 0; ai < 2; ++ai)
#pragma unroll
            for (int m = 0; m < 4; ++m) { const size_t ro = (size_t)(row0 + ai * HALF + m * 16) * 1024 + col0; float s = 0.f;
#pragma unroll
                for (int bj = 0; bj < 2; ++bj) {
                    const f32x4 x0 = __builtin_nontemporal_load((const f32x4*)(X + ro + bj * HALF)), x1 = __builtin_nontemporal_load((const f32x4*)(X + ro + bj * HALF + 4));
                    acc[ai][bj][m][0] = acc[ai][bj][m][0] + x0; acc[ai][bj][m][1] = acc[ai][bj][m][1] + x1;
#pragma unroll
                    for (int n = 0; n < 2; ++n) { const f32x4 v = acc[ai][bj][m][n]; s += (v[0] * v[0] + v[1] * v[1]) + (v[2] * v[2] + v[3] * v[3]); } }
                s += __shfl_xor(s, 16); s += __shfl_xor(s, 32);
                if (fq == 0) ssl[((wr * 4 + wc) * 8 + ai * 4 + m) * 16 + fr] = s; }
        asm volatile("s_waitcnt lgkmcnt(0)" ::: "memory"); __builtin_amdgcn_s_barrier(); asm volatile("" ::: "memory");
        const int rr = t_ & 255, r_ai = rr >> 7, r_wr = (rr >> 6) & 1, r_m = (rr >> 4) & 3, r_fr = rr & 15;
        if (t_ < 256) { float s = 0.f;
#pragma unroll
            for (int c = 0; c < 4; ++c) s += ssl[((r_wr * 4 + c) * 8 + r_ai * 4 + r_m) * 16 + r_fr];
            __hip_atomic_store(part + (size_t)(u.pm * 4 + u.pn) * 256 + rr, s, __ATOMIC_RELAXED, __HIP_MEMORY_SCOPE_AGENT);
            asm volatile("s_waitcnt vmcnt(0)" ::: "memory"); }
        asm volatile("s_waitcnt lgkmcnt(0)" ::: "memory"); __builtin_amdgcn_s_barrier(); asm volatile("" ::: "memory");
        if (t_ == 0) { __hip_atomic_fetch_add(cnt + u.pm, 1u, __ATOMIC_RELAXED, __HIP_MEMORY_SCOPE_AGENT);
            unsigned sp = 0; while (__hip_atomic_load(cnt + u.pm, __ATOMIC_RELAXED, __HIP_MEMORY_SCOPE_AGENT) < 4u && ++sp < (1u << 22)) __builtin_amdgcn_s_sleep(2); }
        asm volatile("s_waitcnt vmcnt(0) lgkmcnt(0)" ::: "memory"); __builtin_amdgcn_s_barrier(); asm volatile("" ::: "memory");
        if (t_ < 256) { float s = 0.f;
#pragma unroll
            for (int c = 0; c < 4; ++c) s += __hip_atomic_load(part + (size_t)(u.pm * 4 + c) * 256 + rr, __ATOMIC_RELAXED, __HIP_MEMORY_SCOPE_AGENT);
            rstd_l[rr] = 1.0f / sqrtf(s * (1.0f / 1024.0f) + 1e-6f); }
        asm volatile("s_waitcnt vmcnt(0) lgkmcnt(0)" ::: "memory"); __builtin_amdgcn_s_barrier(); asm volatile("" ::: "memory");
        f32x4 gv[2][2];
#pragma unroll
        for (int bj = 0; bj < 2; ++bj)
#pragma unroll
            for (int n = 0; n < 2; ++n) gv[bj][n] = *(const f32x4*)(gain + col0 + bj * HALF + 4 * n);
#pragma unroll
        for (int ai = 0; ai < 2; ++ai)
#pragma unroll
            for (int m = 0; m < 4; ++m) { const size_t ro = (size_t)(row0 + ai * HALF + m * 16) * 1024 + col0; const float rs = rstd_l[ai * 128 + wr * 64 + m * 16 + fr];
#pragma unroll
                for (int bj = 0; bj < 2; ++bj) { *(f32x4*)(O + ro + bj * HALF) = (acc[ai][bj][m][0] * rs) * gv[bj][0]; *(f32x4*)(O + ro + bj * HALF + 4) = (acc[ai][bj][m][1] * rs) * gv[bj][1]; } }
        asm volatile("s_waitcnt lgkmcnt(0)" ::: "memory");
    }
};


template <class Epi, class Sched, bool ALIGN_EPI = false, bool SP2 = false>
__device__ __forceinline__ void gemm_phase(PG8_LAS unsigned char* lds, const Gemm g, const Sched& S, const Epi& E) {
    int tid = threadIdx.x; asm volatile("" : "+v"(tid));
    const int wid = __builtin_amdgcn_readfirstlane(tid >> 6), lane = tid & 63, wr = wid >> 2, wc = wid & 3, fr = lane & 15, fq = lane >> 4;
    int K = g.K; asm volatile("" : "+s"(K)); const int nt = K / BK;
    unsigned voffA[2], voffB[2];
#pragma unroll
    for (int i = 0; i < 2; ++i) { int R, C; stage_rc(tid * 16 + i * 8192, R, C); const int Rb = Epi::PERM ? ((R & ~31) + perm32(R & 31)) : R;
        voffA[i] = (unsigned)(R * g.lda + C) * 2u; voffB[i] = (unsigned)(Rb * K + C) * 2u; }
    const size_t kstep = (size_t)(BK * 2);
    const size_t hstepB = (size_t)HALF * K * 2, hstepA = (size_t)HALF * g.lda * 2;
    const size_t tstepB = 2 * hstepB, tstepA = 2 * hstepA;
    const unsigned ldsw = (unsigned)wid * 1024u;
    const int aoff = lds_byte(wr * 64 + fr, fq * 8), boff = lds_byte(wc * 32 + fr, fq * 8);
#define PG8_SA(b, h) (((b) * 2 + (h)) * HTB)
#define PG8_SB(b, h) ((4 + (b) * 2 + (h)) * HTB)
#define PG8_STAGE(bufoff, gbase, voff) do { _Pragma("unroll") for (int _i = 0; _i < 2; ++_i) \
        __builtin_amdgcn_global_load_lds((const unsigned*)((const char*)(gbase) + (voff)[_i]), (PG8_LAS unsigned*)(lds + (bufoff) + ldsw + _i * 8192), 16, 0, 0); } while (0)
#define PG8_LDA(dst, b, h) do { _Pragma("unroll") for (int m = 0; m < 4; ++m) _Pragma("unroll") for (int k = 0; k < 2; ++k) dst[m][k] = *(const PG8_LAS bf16x8*)(lds + PG8_SA(b, h) + aoff + m * 2048 + k * 1024); } while (0)
#define PG8_LDB(dst, b, h) do { _Pragma("unroll") for (int n = 0; n < 2; ++n) _Pragma("unroll") for (int k = 0; k < 2; ++k) dst[n][k] = *(const PG8_LAS bf16x8*)(lds + PG8_SB(b, h) + boff + n * 2048 + k * 1024); } while (0)
#define PG8_MMA(ai, bj, At, Bt) do { __builtin_amdgcn_s_setprio(1); _Pragma("unroll") for (int m = 0; m < 4; ++m) _Pragma("unroll") for (int n = 0; n < 2; ++n) _Pragma("unroll") for (int k = 0; k < 2; ++k) \
        acc[ai][bj][m][n] = __builtin_amdgcn_mfma_f32_16x16x32_bf16(Bt[n][k], At[m][k], acc[ai][bj][m][n], 0, 0, 0); __builtin_amdgcn_s_setprio(0); } while (0)
#define PG8_WAIT_V(n) asm volatile("s_waitcnt vmcnt(" #n ")" ::: "memory")
#define PG8_WAIT_L(n) asm volatile("s_waitcnt lgkmcnt(" #n ")" ::: "memory")
#define PG8_BAR __builtin_amdgcn_s_barrier()
#define PG8_SCHED __builtin_amdgcn_sched_barrier(0)
    Unit cur, nxt; int ui = 0;
    if (!S.next(0, cur)) return;
    f32x4 acc[2][2][4][2];
#pragma unroll
    for (int a = 0; a < 2; ++a)
#pragma unroll
        for (int b = 0; b < 2; ++b)
#pragma unroll
            for (int m = 0; m < 4; ++m)
#pragma unroll
                for (int n = 0; n < 2; ++n) acc[a][b][m][n] = (f32x4){0.f, 0.f, 0.f, 0.f};
    bf16x8 At[4][2], B0[2][2], B1[2][2];
    const char* cA = (const char*)g.A + (size_t)cur.pm * tstepA + (size_t)(cur.pn >> g.apn_shift) * g.apn_bytes; const char* cB = (const char*)g.Bt + (size_t)cur.pn * tstepB;
    S.a_ready(cur);
    if constexpr (SP2) {
        PG8_STAGE(PG8_SB(0, 0), cB, voffB); PG8_STAGE(PG8_SB(0, 1), cB + hstepB, voffB); PG8_STAGE(PG8_SA(0, 0), cA, voffA); PG8_STAGE(PG8_SA(0, 1), cA + hstepA, voffA);
        if (wr == 1) PG8_BAR;
        PG8_WAIT_V(2); PG8_BAR;
        PG8_STAGE(PG8_SB(1, 0), cB + kstep, voffB); PG8_STAGE(PG8_SA(1, 0), cA + kstep, voffA); PG8_STAGE(PG8_SB(1, 1), cB + hstepB + kstep, voffB);
        PG8_WAIT_V(6); PG8_BAR;
    } else {
        PG8_STAGE(PG8_SB(0, 0), cB, voffB); PG8_STAGE(PG8_SA(0, 0), cA, voffA); PG8_STAGE(PG8_SB(0, 1), cB + hstepB, voffB); PG8_STAGE(PG8_SA(0, 1), cA + hstepA, voffA);
        if (wr == 1) PG8_BAR;
        PG8_WAIT_V(4); PG8_BAR;
        PG8_STAGE(PG8_SB(1, 0), cB + kstep, voffB); PG8_STAGE(PG8_SA(1, 0), cA + kstep, voffA); PG8_STAGE(PG8_SB(1, 1), cB + hstepB + kstep, voffB);
        PG8_WAIT_V(6); PG8_BAR;
    }
    for (;;) {
        const bool has_next = S.next(ui + 1, nxt);
        const char* nA = has_next ? (const char*)g.A + (size_t)nxt.pm * tstepA + (size_t)(nxt.pn >> g.apn_shift) * g.apn_bytes : cA; const char* nB = has_next ? (const char*)g.Bt + (size_t)nxt.pn * tstepB : cB;
        for (int t = 0; t < nt; t += 2) {
            const bool last = (t == nt - 2);
            const char* a1 = cA + (size_t)(t + 1) * kstep;
            const char* a2 = last ? nA : cA + (size_t)(t + 2) * kstep; const char* b2 = last ? nB : cB + (size_t)(t + 2) * kstep;
            const char* a3 = a2 + kstep; const char* b3 = b2 + kstep;
            if (last && has_next) S.a_ready(nxt);
            if constexpr (SP2) {
            PG8_LDB(B0, 0, 0); PG8_LDB(B1, 0, 1); PG8_SCHED; PG8_LDA(At, 0, 0); PG8_STAGE(PG8_SA(1, 1), a1 + hstepA, voffA);
            PG8_WAIT_V(8); PG8_WAIT_L(0); PG8_BAR; PG8_MMA(0, 0, At, B0); PG8_MMA(0, 1, At, B1); PG8_BAR; PG8_SCHED;
            PG8_LDA(At, 0, 1); PG8_STAGE(PG8_SB(0, 0), b2, voffB); PG8_STAGE(PG8_SB(0, 1), b2 + hstepB, voffB); PG8_STAGE(PG8_SA(0, 0), a2, voffA);
            PG8_WAIT_V(8); PG8_WAIT_L(0); PG8_BAR; PG8_MMA(1, 0, At, B0); PG8_MMA(1, 1, At, B1); PG8_BAR; PG8_SCHED;
            PG8_LDB(B0, 1, 0); PG8_LDB(B1, 1, 1); PG8_SCHED; PG8_LDA(At, 1, 0); PG8_STAGE(PG8_SA(0, 1), a2 + hstepA, voffA);
            PG8_WAIT_V(8); PG8_WAIT_L(0); PG8_BAR; PG8_MMA(0, 0, At, B0); PG8_MMA(0, 1, At, B1); PG8_BAR; PG8_SCHED;
            PG8_LDA(At, 1, 1); PG8_STAGE(PG8_SB(1, 0), b3, voffB); PG8_STAGE(PG8_SB(1, 1), b3 + hstepB, voffB); PG8_STAGE(PG8_SA(1, 0), a3, voffA);
            PG8_WAIT_V(8); PG8_WAIT_L(0); PG8_BAR; PG8_MMA(1, 0, At, B0); PG8_MMA(1, 1, At, B1); PG8_BAR; PG8_SCHED;
            } else {
            PG8_LDB(B0, 0, 0); PG8_SCHED; PG8_LDA(At, 0, 0); PG8_STAGE(PG8_SA(1, 1), a1 + hstepA, voffA);
            PG8_WAIT_L(8); PG8_BAR; PG8_WAIT_L(0); PG8_MMA(0, 0, At, B0); PG8_BAR; PG8_SCHED;
            PG8_LDB(B1, 0, 1); PG8_STAGE(PG8_SB(0, 0), b2, voffB);
            PG8_BAR; PG8_WAIT_L(0); PG8_MMA(0, 1, At, B1); PG8_BAR;
            PG8_LDA(At, 0, 1); PG8_STAGE(PG8_SA(0, 0), a2, voffA);
            PG8_BAR; PG8_WAIT_L(0); PG8_MMA(1, 0, At, B0); PG8_BAR; PG8_SCHED;
            PG8_STAGE(PG8_SB(0, 1), b2 + hstepB, voffB);
            PG8_WAIT_V(6); PG8_BAR; PG8_MMA(1, 1, At, B1); PG8_BAR;
            PG8_LDB(B0, 1, 0); PG8_SCHED; PG8_LDA(At, 1, 0); PG8_STAGE(PG8_SA(0, 1), a2 + hstepA, voffA);
            PG8_WAIT_L(8); PG8_BAR; PG8_WAIT_L(0); PG8_MMA(0, 0, At, B0); PG8_BAR; PG8_SCHED;
            PG8_LDB(B1, 1, 1); PG8_STAGE(PG8_SB(1, 0), b3, voffB);
            PG8_BAR; PG8_WAIT_L(0); PG8_MMA(0, 1, At, B1); PG8_BAR;
            PG8_LDA(At, 1, 1); PG8_STAGE(PG8_SA(1, 0), a3, voffA);
            PG8_BAR; PG8_WAIT_L(0); PG8_MMA(1, 0, At, B0); PG8_BAR; PG8_SCHED;
            PG8_STAGE(PG8_SB(1, 1), b3 + hstepB, voffB);
            PG8_WAIT_V(6); PG8_BAR; PG8_MMA(1, 1, At, B1); PG8_BAR;
            }
        }
        if constexpr (ALIGN_EPI) { if (wr == 0) PG8_BAR; }
        if constexpr (!Epi::AFTER_DRAIN) { E(acc, cur, wr, wc, fr, fq); S.done(cur); }
        if (!has_next) break;
#pragma unroll
        for (int a = 0; a < 2; ++a)
#pragma unroll
            for (int b = 0; b < 2; ++b)
#pragma unroll
                for (int m = 0; m < 4; ++m)
#pragma unroll
                    for (int n = 0; n < 2; ++n) acc[a][b][m][n] = (f32x4){0.f, 0.f, 0.f, 0.f};
        cur = nxt; cA = nA; cB = nB; ++ui;
        if constexpr (ALIGN_EPI) { if (wr == 1) PG8_BAR; }
    }
    PG8_WAIT_V(0);
    if constexpr (!ALIGN_EPI) { if (wr == 0) PG8_BAR; }
    PG8_BAR;
    if constexpr (Epi::AFTER_DRAIN) { E.fused(acc, cur, wr, wc, fr, fq, lds, wid, lane); S.done(cur); }
#undef PG8_SA
#undef PG8_SB
#undef PG8_STAGE
#undef PG8_LDA
#undef PG8_LDB
#undef PG8_MMA
#undef PG8_WAIT_V
#undef PG8_WAIT_L
#undef PG8_BAR
#undef PG8_SCHED
}
}

#define LAS __attribute__((address_space(3)))
typedef unsigned short bf16;
typedef pg8::f32x4 f32x4;
typedef pg8::u32x4 u32x4;
typedef pg8::u32x2 u32x2;
typedef float f32x2 __attribute__((ext_vector_type(2)));
typedef pg8::bf16x8 bf16x8;
using pg8::cvt_pk_bf16; using pg8::bf_lo; using pg8::bf_hi; using pg8::fsigmoid;

constexpr int M = 32768, D = 1024, SEQ = 2048, NB = 16, NHEAD = 8;
constexpr int ZCOLS = 6144;
constexpr size_t SLOT = (size_t)M * D * 2;
constexpr size_t WS_H = 0 * SLOT, WS_XA = 1 * SLOT, WS_GA = 2 * SLOT, WS_Q = 3 * SLOT, WS_F = 4 * SLOT, WS_I = 5 * SLOT, WS_GB = 6 * SLOT, WS_MISC = 7 * SLOT;
constexpr size_t MS_WIN = 0, MS_PA = (size_t)16 << 20, MS_PB = (size_t)18 << 20, MS_WO = (size_t)20 << 20, MS_GBT = (size_t)22 << 20, MS_SP8 = (size_t)23 << 20, MS_BAR = ((size_t)23 << 20) + 4096, MS_CNT = MS_BAR + 14336, MS_PART = (size_t)24 << 20, MS_END = ((size_t)24 << 20) + ((size_t)1 << 20);
constexpr size_t WS_NEED = WS_MISC + MS_END;
constexpr int LDS_BYTES = 144 * 1024;
constexpr float EPS = 1e-6f;
constexpr float L2E = 1.44269504089f;

__device__ __forceinline__ float wave_sum(float v) {
#pragma unroll
    for (int o = 1; o < 64; o <<= 1) v += __shfl_xor(v, o);
    return v;
}
__device__ __forceinline__ float fsilu(float x) { return x * fsigmoid(x); }

__device__ __forceinline__ void p0_transpose_item(const float* W, int K, int N, bf16* WT, LAS float* scr, int item, int lane) {
    const int nblk = N / 32, kb = item / nblk, nb = item % nblk, k0 = 64 * kb, n0 = 32 * nb;
#pragma unroll 8
    for (int i = 0; i < 32; ++i) { const int kk = 2 * i + (lane >> 5); scr[kk * 33 + (lane & 31)] = __builtin_nontemporal_load(W + (size_t)(k0 + kk) * N + n0 + (lane & 31)); }
    asm volatile("s_waitcnt lgkmcnt(0)" ::: "memory");
    const int c = lane & 7;
#pragma unroll
    for (int j = 0; j < 4; ++j) { const int n = (lane >> 3) + 8 * j; const LAS float* s = scr + (8 * c) * 33 + n;
        u32x4 o; o.x = cvt_pk_bf16(s[0 * 33], s[1 * 33]); o.y = cvt_pk_bf16(s[2 * 33], s[3 * 33]); o.z = cvt_pk_bf16(s[4 * 33], s[5 * 33]); o.w = cvt_pk_bf16(s[6 * 33], s[7 * 33]);
        *(u32x4*)(WT + (size_t)(n0 + n) * K + k0 + 8 * c) = o; }
    asm volatile("s_waitcnt lgkmcnt(0)" ::: "memory");
}
template <int NR> __device__ __forceinline__ void rms_rows_to_bf16(const float* X, const float* g, bf16* O, int m0, int stride, int lane) {
    f32x4 v[NR][4]; float s[NR];
#pragma unroll
    for (int r = 0; r < NR; ++r) { const f32x4* xr = (const f32x4*)(X + (size_t)(m0 + r * stride) * D) + lane;
#pragma unroll
        for (int j = 0; j < 4; ++j) v[r][j] = __builtin_nontemporal_load(xr + 64 * j); }
    f32x4 gg[4];
#pragma unroll
    for (int j = 0; j < 4; ++j) gg[j] = ((const f32x4*)g + lane)[64 * j];
#pragma unroll
    for (int r = 0; r < NR; ++r) { float a = 0.f;
#pragma unroll
        for (int j = 0; j < 4; ++j) a += (v[r][j].x * v[r][j].x + v[r][j].y * v[r][j].y) + (v[r][j].z * v[r][j].z + v[r][j].w * v[r][j].w);
        s[r] = a; }
#pragma unroll
    for (int o = 1; o < 64; o <<= 1) {
#pragma unroll
        for (int r = 0; r < NR; ++r) s[r] += __shfl_xor(s[r], o); }
#pragma unroll
    for (int r = 0; r < NR; ++r) { const float rstd = 1.0f / sqrtf(s[r] * (1.f / D) + EPS); u32x2* o8 = (u32x2*)(O + (size_t)(m0 + r * stride) * D) + lane;
#pragma unroll
        for (int j = 0; j < 4; ++j) { u32x2 o; o.x = cvt_pk_bf16(v[r][j].x * rstd * gg[j].x, v[r][j].y * rstd * gg[j].y); o.y = cvt_pk_bf16(v[r][j].z * rstd * gg[j].z, v[r][j].w * rstd * gg[j].w); o8[64 * j] = o; } }
}
template <int NR> __device__ __forceinline__ void rms_rows_inplace(float* X, const float* g, int m0, int stride, int lane) {
    f32x4 v[NR][4]; float s[NR];
#pragma unroll
    for (int r = 0; r < NR; ++r) { const f32x4* xr = (const f32x4*)(X + (size_t)(m0 + r * stride) * D) + lane;
#pragma unroll
        for (int j = 0; j < 4; ++j) v[r][j] = xr[64 * j]; }
    f32x4 gg[4];
#pragma unroll
    for (int j = 0; j < 4; ++j) gg[j] = ((const f32x4*)g + lane)[64 * j];
#pragma unroll
    for (int r = 0; r < NR; ++r) { float a = 0.f;
#pragma unroll
        for (int j = 0; j < 4; ++j) a += (v[r][j].x * v[r][j].x + v[r][j].y * v[r][j].y) + (v[r][j].z * v[r][j].z + v[r][j].w * v[r][j].w);
        s[r] = a; }
#pragma unroll
    for (int o = 1; o < 64; o <<= 1) {
#pragma unroll
        for (int r = 0; r < NR; ++r) s[r] += __shfl_xor(s[r], o); }
#pragma unroll
    for (int r = 0; r < NR; ++r) { const float rstd = 1.0f / sqrtf(s[r] * (1.f / D) + EPS); f32x4* xr = (f32x4*)(X + (size_t)(m0 + r * stride) * D) + lane;
#pragma unroll
        for (int j = 0; j < 4; ++j) xr[64 * j] = (v[r][j] * rstd) * gg[j]; }
}

struct Params {
    const float *x, *w_in, *b_merge, *conv_w, *conv_b, *rg_wx, *rg_bx, *rg_wa, *rg_ba, *rg_lambda, *hg_lb, *hg_norm_g, *proj_a, *proj_b, *w_out, *norm_g, *final_g;
    float* out; unsigned char* ws; unsigned* bar; int use_cg_sync; int pad;
};

__device__ __forceinline__ void p0_prologue(const Params& P, LAS unsigned char* lds, int wave, int lane) {
    unsigned char* ms = P.ws + WS_MISC;
    LAS float* scr = (LAS float*)(lds + wave * 16384);
    const int G = gridDim.x, gw = blockIdx.x * 8 + wave, NGW = G * 8;
    constexpr int I_IN = (D / 64) * (8192 / 32), I_P = (D / 64) * (D / 32);
    for (int it = gw; it < I_IN + 3 * I_P; it += NGW) {
        int r = it;
        if (r < I_IN) { p0_transpose_item(P.w_in, D, 8192, (bf16*)(ms + MS_WIN), scr, r, lane); continue; } r -= I_IN;
        if (r < I_P) { p0_transpose_item(P.proj_a, D, D, (bf16*)(ms + MS_PA), scr, r, lane); continue; } r -= I_P;
        if (r < I_P) { p0_transpose_item(P.proj_b, D, D, (bf16*)(ms + MS_PB), scr, r, lane); continue; } r -= I_P;
        p0_transpose_item(P.w_out, D, D, (bf16*)(ms + MS_WO), scr, r, lane);
    }
    { bf16* GB = (bf16*)(ms + MS_GBT); const int gt = blockIdx.x * 512 + wave * 64 + lane, GT = G * 512;
      for (int e = gt; e < 2048 * 256; e += GT) { const int cl = e & 127, k = (e >> 7) & 255, gate = (e >> 15) & 1, blk = e >> 16;
          const int kin = k - 128 * (blk & 1); float v = 0.f;
          if (kin >= 0 && kin < 128) v = (gate ? P.rg_wa : P.rg_wx)[((size_t)blk * 128 + kin) * 128 + cl];
          GB[(size_t)(256 * blk + 128 * gate + cl) * 256 + k] = (bf16)(cvt_pk_bf16(v, 0.f) & 0xffffu); }
      float* sp8 = (float*)(ms + MS_SP8);
      for (int e = gt; e < D; e += GT) sp8[e] = 8.0f * log1pf(expf(-P.rg_lambda[e])); }
    bf16* H = (bf16*)(P.ws + WS_H);
    for (int m = gw; m < M; m += 4 * NGW) rms_rows_to_bf16<4>(P.x, P.norm_g, H, m, NGW, lane);
}

constexpr int HG_QIN = 0, HG_KIN = 17408, HG_QINT = 34816, HG_KST = 52224, HG_VT = 70656, HG_ATT = 89088, HG_ST = 98304, HG_TOT = 133120, HG_LF = 137216, HG_DEC = 137728, HG_SSQ = 138240;
__device__ __forceinline__ bf16x8 lds_frag(LAS unsigned char* p) { return *(const LAS bf16x8*)p; }

#define HG_PREP1(NXT_ROW)                                                                                                   \
    _Pragma("unroll") for (int tt = 0; tt < 8; ++tt) { _Pragma("unroll") for (int c = 0; c < 2; ++c) {                     \
        const float fp = c ? bf_hi(rf[tt]) : bf_lo(rf[tt]);                                                                 \
        { const float qv_ = c ? bf_hi(rq[tt]) : bf_lo(rq[tt]); qh[tt][c] = S1_SILU ? qv_ : fsilu(qv_) * 0.08838834764831845f; } vv[tt][c] = c ? bf_hi(ri[tt]) : bf_lo(ri[tt]); \
        const float sg = fsigmoid(fp), f = lb[c] + (1.0f - lb[c]) * sg;                                                     \
        kk[tt][c] = (1.0f - lb[c]) * (1.0f - sg); pf[tt][c] = tt ? f * pf[tt - 1][c] : f; } }                               \
    *(LAS f32x2*)(lds + HG_TOT + (w * 128 + d0) * 4) = (f32x2){pf[7][0], pf[7][1]};                                         \
    if (w == 4) *(LAS f32x2*)(lds + HG_LF + d0 * 4) = (f32x2){pf[0][0], pf[0][1]};                                          \
    if ((NXT_ROW) < row0 + SEQ) { _Pragma("unroll") for (int tt = 0; tt < 8; ++tt) { const size_t o = ((NXT_ROW) + w * 8 + tt) * D + colq; \
        rq[tt] = __builtin_nontemporal_load((const unsigned*)(Qs + o)); rf[tt] = __builtin_nontemporal_load((const unsigned*)(Fs + o)); ri[tt] = __builtin_nontemporal_load((const unsigned*)(Is + o)); } }
__device__ __forceinline__ void hgrn_item2(const Params& P, LAS unsigned char* lds, int b, int hd, int w, int l, bf16* YB) {
    const bf16* Qs = (const bf16*)(P.ws + WS_Q); const bf16* Fs = (const bf16*)(P.ws + WS_F); const bf16* Is = (const bf16*)(P.ws + WS_I); const bf16* GBs = (const bf16*)(P.ws + WS_GB);
    const int fr = l & 15, fq = l >> 4, ti = w >> 1, wh = w & 1, th = w >> 2, vq = w & 3;
    const int d0 = 2 * l;
    float lb[2];
#pragma unroll
    for (int c = 0; c < 2; ++c) { const float l0 = P.hg_lb[hd * 128 + d0 + c], l1 = P.hg_lb[D + hd * 128 + d0 + c]; lb[c] = 1.0f / (1.0f + expf(l1 - l0)); }
    f32x4 gn[2];
#pragma unroll
    for (int vv2 = 0; vv2 < 2; ++vv2) gn[vv2] = *(const f32x4*)(P.hg_norm_g + 16 * (2 * vq + vv2) + 4 * fq);
    f32x4 S[4][2];
#pragma unroll
    for (int i = 0; i < 4; ++i) { S[i][0] = (f32x4){0.f, 0.f, 0.f, 0.f}; S[i][1] = S[i][0]; }
    __syncthreads();
    for (int e = w * 64 + l; e < 34816 / 4; e += 512) ((LAS unsigned*)(lds + HG_ST))[e] = 0u;
    const size_t row0 = (size_t)b * SEQ;
    const int colq = hd * 128 + d0;
    unsigned rq[8], rf[8], ri[8];
#pragma unroll
    for (int tt = 0; tt < 8; ++tt) { const size_t o = (row0 + w * 8 + tt) * D + colq; rq[tt] = __builtin_nontemporal_load((const unsigned*)(Qs + o)); rf[tt] = __builtin_nontemporal_load((const unsigned*)(Fs + o)); ri[tt] = __builtin_nontemporal_load((const unsigned*)(Is + o)); }
    float qh[8][2], kk[8][2], pf[8][2], vv[8][2];
    HG_PREP1(row0 + 64)
    __syncthreads();
    for (int n = 0; n < 32; ++n) {
        const size_t crow = row0 + (size_t)n * 64;
        u32x2 gbv[2][2];
#pragma unroll
        for (int tt2 = 0; tt2 < 2; ++tt2)
#pragma unroll
            for (int vv2 = 0; vv2 < 2; ++vv2) gbv[tt2][vv2] = __builtin_nontemporal_load((const u32x2*)(GBs + (crow + 16 * (2 * th + tt2) + fr) * D + hd * 128 + 16 * (2 * vq + vv2) + 4 * fq));
        { float off[2] = {1.f, 1.f}, pmid[2] = {1.f, 1.f}, plast[2] = {1.f, 1.f};
#pragma unroll
          for (int g = 0; g < 8; ++g) { const f32x2 t2 = *(const LAS f32x2*)(lds + HG_TOT + (g * 128 + d0) * 4);
              if (g < w) { off[0] *= t2.x; off[1] *= t2.y; }
              if (g < 4) { pmid[0] *= t2.x; pmid[1] *= t2.y; }
              plast[0] *= t2.x; plast[1] *= t2.y; }
          { const f32x2 t2 = *(const LAS f32x2*)(lds + HG_LF + d0 * 4); pmid[0] *= t2.x; pmid[1] *= t2.y; }
          float rpmid[2];
#pragma unroll
          for (int c = 0; c < 2; ++c) rpmid[c] = __builtin_amdgcn_rcpf(pmid[c]);
          if (w == 0) *(LAS f32x2*)(lds + HG_DEC + d0 * 4) = (f32x2){plast[0], plast[1]};
          float kst[8][2];
#pragma unroll
          for (int tt = 0; tt < 8; ++tt) {
              float qin[2], kin[2], qint[2];
#pragma unroll
              for (int c = 0; c < 2; ++c) {
                  const float Pt = off[c] * pf[tt][c], rP = __builtin_amdgcn_rcpf(Pt);
                  qint[c] = qh[tt][c] * Pt; qin[c] = qint[c] * rpmid[c];
                  const float kr = kk[tt][c] * rP; kin[c] = kr * pmid[c]; kst[tt][c] = kr * plast[c];
              }
              const int t = w * 8 + tt;
              *(LAS unsigned*)(lds + HG_QIN + t * 272 + d0 * 2) = cvt_pk_bf16(qin[0], qin[1]);
              *(LAS unsigned*)(lds + HG_KIN + t * 272 + d0 * 2) = cvt_pk_bf16(kin[0], kin[1]);
              *(LAS unsigned*)(lds + HG_QINT + t * 272 + d0 * 2) = cvt_pk_bf16(qint[0], qint[1]);
          }
#pragma unroll
          for (int c = 0; c < 2; ++c) {
              u32x4 pk, pv;
              pk.x = cvt_pk_bf16(kst[0][c], kst[1][c]); pk.y = cvt_pk_bf16(kst[2][c], kst[3][c]); pk.z = cvt_pk_bf16(kst[4][c], kst[5][c]); pk.w = cvt_pk_bf16(kst[6][c], kst[7][c]);
              pv.x = cvt_pk_bf16(vv[0][c], vv[1][c]); pv.y = cvt_pk_bf16(vv[2][c], vv[3][c]); pv.z = cvt_pk_bf16(vv[4][c], vv[5][c]); pv.w = cvt_pk_bf16(vv[6][c], vv[7][c]);
              *(LAS u32x4*)(lds + HG_KST + (d0 + c) * 144 + w * 16) = pk;
              *(LAS u32x4*)(lds + HG_VT + (d0 + c) * 144 + w * 16) = pv;
          } }
        __syncthreads();
        if (n < 31) { HG_PREP1(crow + 128) }
        { bf16x8 yq[4];
#pragma unroll
          for (int ks = 0; ks < 4; ++ks) yq[ks] = lds_frag(lds + HG_QIN + (16 * ti + fr) * 272 + ks * 64 + fq * 16);
#pragma unroll
          for (int sjj = 0; sjj < 2; ++sjj) { const int sj = wh * 2 + sjj;
              f32x4 a = (f32x4){0.f, 0.f, 0.f, 0.f};
#pragma unroll
              for (int ks = 0; ks < 4; ++ks) a = __builtin_amdgcn_mfma_f32_16x16x32_bf16(lds_frag(lds + HG_KIN + (16 * sj + fr) * 272 + ks * 64 + fq * 16), yq[ks], a, 0, 0, 0);
              const int t = 16 * ti + fr, s0 = 16 * sj + 4 * fq;
#pragma unroll
              for (int j = 0; j < 4; ++j) a[j] = (s0 + j <= t) ? a[j] : 0.f;
              u32x2 pk; pk.x = cvt_pk_bf16(a[0], a[1]); pk.y = cvt_pk_bf16(a[2], a[3]);
              *(LAS u32x2*)(lds + HG_ATT + (16 * ti + fr) * 144 + (16 * sj + 4 * fq) * 2) = pk; } }
        f32x4 oa[2][2];
#pragma unroll
        for (int i = 0; i < 2; ++i) { oa[i][0] = (f32x4){0.f, 0.f, 0.f, 0.f}; oa[i][1] = oa[i][0]; }
#pragma unroll
        for (int ks = 0; ks < 4; ++ks) {
            bf16x8 yf[2], xf[2];
#pragma unroll
            for (int i = 0; i < 2; ++i) { yf[i] = lds_frag(lds + HG_QINT + (16 * (2 * th + i) + fr) * 272 + ks * 64 + fq * 16); xf[i] = lds_frag(lds + HG_ST + (16 * (2 * vq + i) + fr) * 272 + ks * 64 + fq * 16); }
#pragma unroll
            for (int tt2 = 0; tt2 < 2; ++tt2)
#pragma unroll
                for (int vv2 = 0; vv2 < 2; ++vv2) oa[tt2][vv2] = __builtin_amdgcn_mfma_f32_16x16x32_bf16(xf[vv2], yf[tt2], oa[tt2][vv2], 0, 0, 0);
        }
        __syncthreads();
#pragma unroll
        for (int ks = 0; ks < 2; ++ks) {
            bf16x8 yf[2], xf[2];
#pragma unroll
            for (int i = 0; i < 2; ++i) { yf[i] = lds_frag(lds + HG_ATT + (16 * (2 * th + i) + fr) * 144 + ks * 64 + fq * 16); xf[i] = lds_frag(lds + HG_VT + (16 * (2 * vq + i) + fr) * 144 + ks * 64 + fq * 16); }
#pragma unroll
            for (int tt2 = 0; tt2 < 2; ++tt2)
#pragma unroll
                for (int vv2 = 0; vv2 < 2; ++vv2) oa[tt2][vv2] = __builtin_amdgcn_mfma_f32_16x16x32_bf16(xf[vv2], yf[tt2], oa[tt2][vv2], 0, 0, 0);
        }
#pragma unroll
        for (int tt2 = 0; tt2 < 2; ++tt2) { float ss = 0.f;
#pragma unroll
            for (int vv2 = 0; vv2 < 2; ++vv2) ss += (oa[tt2][vv2][0] * oa[tt2][vv2][0] + oa[tt2][vv2][1] * oa[tt2][vv2][1]) + (oa[tt2][vv2][2] * oa[tt2][vv2][2] + oa[tt2][vv2][3] * oa[tt2][vv2][3]);
            ss += __shfl_xor(ss, 16); ss += __shfl_xor(ss, 32);
            if (fq == 0) *(LAS float*)(lds + HG_SSQ + (vq * 64 + 16 * (2 * th + tt2) + fr) * 4) = ss; }
#pragma unroll
        for (int dd = 0; dd < 4; ++dd) { const f32x4 dec = *(const LAS f32x4*)(lds + HG_DEC + (16 * (4 * th + dd) + 4 * fq) * 4);
            S[dd][0] = S[dd][0] * dec; S[dd][1] = S[dd][1] * dec; }
#pragma unroll
        for (int ks = 0; ks < 2; ++ks) {
            bf16x8 yv[2];
#pragma unroll
            for (int i = 0; i < 2; ++i) yv[i] = lds_frag(lds + HG_VT + (16 * (2 * vq + i) + fr) * 144 + ks * 64 + fq * 16);
#pragma unroll
            for (int dd = 0; dd < 4; ++dd) { const bf16x8 xk = lds_frag(lds + HG_KST + (16 * (4 * th + dd) + fr) * 144 + ks * 64 + fq * 16);
                S[dd][0] = __builtin_amdgcn_mfma_f32_16x16x32_bf16(xk, yv[0], S[dd][0], 0, 0, 0);
                S[dd][1] = __builtin_amdgcn_mfma_f32_16x16x32_bf16(xk, yv[1], S[dd][1], 0, 0, 0); }
        }
#pragma unroll
        for (int dd = 0; dd < 4; ++dd)
#pragma unroll
            for (int vv2 = 0; vv2 < 2; ++vv2) { const f32x4 sv = S[dd][vv2]; u32x2 pk; pk.x = cvt_pk_bf16(sv[0], sv[1]); pk.y = cvt_pk_bf16(sv[2], sv[3]);
                *(LAS u32x2*)(lds + HG_ST + (16 * (2 * vq + vv2) + fr) * 272 + (16 * (4 * th + dd) + 4 * fq) * 2) = pk; }
        __syncthreads();
#pragma unroll
        for (int tt2 = 0; tt2 < 2; ++tt2) { const int t = 16 * (2 * th + tt2) + fr;
            const float tot = (*(const LAS float*)(lds + HG_SSQ + t * 4) + *(const LAS float*)(lds + HG_SSQ + (64 + t) * 4)) + (*(const LAS float*)(lds + HG_SSQ + (128 + t) * 4) + *(const LAS float*)(lds + HG_SSQ + (192 + t) * 4));
            const float rstd = 1.0f / sqrtf(tot * (1.f / 128.f) + EPS);
#pragma unroll
            for (int vv2 = 0; vv2 < 2; ++vv2) {
                const size_t o = (crow + t) * D + hd * 128 + 16 * (2 * vq + vv2) + 4 * fq;
                const u32x2 g2 = gbv[tt2][vv2]; const f32x4 ov = oa[tt2][vv2];
                float g0 = bf_lo(g2.x), g1 = bf_hi(g2.x), g2f = bf_lo(g2.y), g3 = bf_hi(g2.y);
                if (!S1_SILU) { g0 = fsilu(g0); g1 = fsilu(g1); g2f = fsilu(g2f); g3 = fsilu(g3); }
                u32x2 pk; pk.x = cvt_pk_bf16(ov[0] * rstd * gn[vv2][0] * g0, ov[1] * rstd * gn[vv2][1] * g1);
                pk.y = cvt_pk_bf16(ov[2] * rstd * gn[vv2][2] * g2f, ov[3] * rstd * gn[vv2][3] * g3);
                *(u32x2*)(YB + o) = pk; } }
    }
    __syncthreads();
}

constexpr int LR_XCS = 0, LR_XCT = 17408, LR_GAT = 35840, LR_YAS = 54272;
__device__ __forceinline__ void lru_item(const Params& P, LAS unsigned char* lds, int b, int blk, int w, int l, bf16* YA) {
    const bf16* XA = (const bf16*)(P.ws + WS_XA); const bf16* GA = (const bf16*)(P.ws + WS_GA);
    const bf16* GBT = (const bf16*)(P.ws + WS_MISC + MS_GBT); const float* sp8 = (const float*)(P.ws + WS_MISC + MS_SP8);
    const int fr = l & 15, fq = l >> 4, c0 = 2 * l, chg = blk * 128;
    float cw[4][2], cb[2];
#pragma unroll
    for (int c = 0; c < 2; ++c) { cb[c] = P.conv_b[chg + c0 + c];
#pragma unroll
        for (int k = 0; k < 4; ++k) cw[k][c] = P.conv_w[k * D + chg + c0 + c]; }
    bf16x8 wfx[4], wfa[4];
#pragma unroll
    for (int ks = 0; ks < 4; ++ks) { const bf16* r = GBT + (size_t)(256 * blk + 16 * w + fr) * 256 + 128 * (blk & 1) + 32 * ks + 8 * fq;
        wfx[ks] = *(const bf16x8*)r; wfa[ks] = *(const bf16x8*)(r + 128 * 256); }
    const int ch = chg + 16 * w + fr;
    const float bxv = P.rg_bx[ch], bav = P.rg_ba[ch], spv = sp8[ch] * L2E;
    float hc = 0.f;
    const size_t row0 = (size_t)b * SEQ; const int col = chg + c0;
    unsigned rx[11], rg[8];
#pragma unroll
    for (int i = 0; i < 11; ++i) { const int tp = 8 * w + i - 3; rx[i] = (tp >= 0) ? *(const unsigned*)(XA + (row0 + tp) * D + col) : 0u; }
#pragma unroll
    for (int tt = 0; tt < 8; ++tt) rg[tt] = __builtin_nontemporal_load((const unsigned*)(GA + (row0 + 8 * w + tt) * D + col));
    __syncthreads();
    for (int n = 0; n < 32; ++n) {
        const size_t crow = row0 + (size_t)n * 64;
        float xc[8][2];
#pragma unroll
        for (int tt = 0; tt < 8; ++tt)
#pragma unroll
            for (int c = 0; c < 2; ++c) { float a = cb[c];
#pragma unroll
                for (int k = 0; k < 4; ++k) a += cw[k][c] * (c ? bf_hi(rx[tt + k]) : bf_lo(rx[tt + k]));
                xc[tt][c] = a; }
#pragma unroll
        for (int tt = 0; tt < 8; ++tt) *(LAS unsigned*)(lds + LR_XCS + (8 * w + tt) * 272 + c0 * 2) = cvt_pk_bf16(xc[tt][0], xc[tt][1]);
#pragma unroll
        for (int c = 0; c < 2; ++c) {
            u32x4 px, pg;
            px.x = cvt_pk_bf16(xc[0][c], xc[1][c]); px.y = cvt_pk_bf16(xc[2][c], xc[3][c]); px.z = cvt_pk_bf16(xc[4][c], xc[5][c]); px.w = cvt_pk_bf16(xc[6][c], xc[7][c]);
            if (c == 0) { pg.x = (rg[0] & 0xffffu) | (rg[1] << 16); pg.y = (rg[2] & 0xffffu) | (rg[3] << 16); pg.z = (rg[4] & 0xffffu) | (rg[5] << 16); pg.w = (rg[6] & 0xffffu) | (rg[7] << 16); }
            else        { pg.x = (rg[0] >> 16) | (rg[1] & 0xffff0000u); pg.y = (rg[2] >> 16) | (rg[3] & 0xffff0000u); pg.z = (rg[4] >> 16) | (rg[5] & 0xffff0000u); pg.w = (rg[6] >> 16) | (rg[7] & 0xffff0000u); }
            *(LAS u32x4*)(lds + LR_XCT + (c0 + c) * 144 + w * 16) = px;
            *(LAS u32x4*)(lds + LR_GAT + (c0 + c) * 144 + w * 16) = pg;
        }
        if (n < 31) {
#pragma unroll
            for (int i = 0; i < 11; ++i) rx[i] = *(const unsigned*)(XA + (crow + 64 + 8 * w + i - 3) * D + col);
#pragma unroll
            for (int tt = 0; tt < 8; ++tt) rg[tt] = __builtin_nontemporal_load((const unsigned*)(GA + (crow + 64 + 8 * w + tt) * D + col));
        }
        __syncthreads();
        f32x4 ax[4], aa[4];
#pragma unroll
        for (int tj = 0; tj < 4; ++tj) { ax[tj] = (f32x4){0.f, 0.f, 0.f, 0.f}; aa[tj] = ax[tj];
#pragma unroll
            for (int ks = 0; ks < 4; ++ks) { const bf16x8 xf = lds_frag(lds + LR_XCS + (16 * tj + fr) * 272 + ks * 64 + fq * 16);
                ax[tj] = __builtin_amdgcn_mfma_f32_16x16x32_bf16(xf, wfx[ks], ax[tj], 0, 0, 0);
                aa[tj] = __builtin_amdgcn_mfma_f32_16x16x32_bf16(xf, wfa[ks], aa[tj], 0, 0, 0); } }
#pragma unroll
        for (int tj = 0; tj < 4; ++tj) {
            const u32x2 xp = *(const LAS u32x2*)(lds + LR_XCT + (16 * w + fr) * 144 + (16 * tj + 4 * fq) * 2);
            const u32x2 gp = *(const LAS u32x2*)(lds + LR_GAT + (16 * w + fr) * 144 + (16 * tj + 4 * fq) * 2);
            const float xv[4] = {bf_lo(xp.x), bf_hi(xp.x), bf_lo(xp.y), bf_hi(xp.y)}, gv[4] = {bf_lo(gp.x), bf_hi(gp.x), bf_lo(gp.y), bf_hi(gp.y)};
            float hl[4], Ac[4];
#pragma unroll
            for (int j = 0; j < 4; ++j) {
                const float gi = fsigmoid(ax[tj][j] + bxv), gr = fsigmoid(aa[tj][j] + bav);
                const float a = __builtin_amdgcn_exp2f(-gr * spv);
                const float u = __builtin_amdgcn_sqrtf(fmaxf(1.0f - a * a, 0.f)) * gi * xv[j];
                hl[j] = j ? a * hl[j - 1] + u : u; Ac[j] = j ? a * Ac[j - 1] : a;
            }
            float Ag = Ac[3], Hg = hl[3];
            { const float A1 = __shfl_up(Ag, 16), H1 = __shfl_up(Hg, 16); if (fq >= 1) { Hg = Ag * H1 + Hg; Ag = Ag * A1; } }
            { const float A2 = __shfl_up(Ag, 32), H2 = __shfl_up(Hg, 32); if (fq >= 2) { Hg = Ag * H2 + Hg; Ag = Ag * A2; } }
            float Ae = __shfl_up(Ag, 16), He = __shfl_up(Hg, 16); if (fq == 0) { Ae = 1.f; He = 0.f; }
            const float At = __shfl(Ag, 48 + fr), Ht = __shfl(Hg, 48 + fr);
            const float hstart = Ae * hc + He;
#pragma unroll
            for (int j = 0; j < 4; ++j) { const float y = (hl[j] + Ac[j] * hstart) * fsilu(gv[j]);
                *(LAS unsigned short*)(lds + LR_YAS + (16 * tj + 4 * fq + j) * 272 + (16 * w + fr) * 2) = (unsigned short)(cvt_pk_bf16(y, 0.f) & 0xffffu); }
            hc = At * hc + Ht;
        }
        asm volatile("s_waitcnt vmcnt(0)" ::: "memory");
        __syncthreads();
#pragma unroll
        for (int tt = 0; tt < 8; ++tt) *(unsigned*)(YA + (crow + 8 * w + tt) * D + col) = *(const LAS unsigned*)(lds + LR_YAS + (8 * w + tt) * 272 + c0 * 2);
    }
    __syncthreads();
}

#define XB_TMO      128
#define XB_XCNT(j)  (256  + 64 * (j))
#define XB_XSUB(j)  (1280 + 64 * (j))
#define XB_XGEN(j)  (2304 + 64 * (j))
#define XB_TOP      3328
#define XB_TOPGEN   3392
#define XCD_BAR_WORDS 3456
#define XB_SPIN_CAP (1u << 18)

__device__ __forceinline__ unsigned xb_ld(unsigned* p)              { return __hip_atomic_load(p, __ATOMIC_RELAXED, __HIP_MEMORY_SCOPE_AGENT); }
__device__ __forceinline__ unsigned xb_add(unsigned* p, unsigned v) { return __hip_atomic_fetch_add(p, v, __ATOMIC_RELAXED, __HIP_MEMORY_SCOPE_AGENT); }
__device__ __forceinline__ unsigned xb_xcc_id() { return (unsigned)__builtin_amdgcn_s_getreg((3 << 11) | 20) & 0xFu; }
#define XB_SPIN(cond, bar) do { unsigned _sp = 0; while (cond) { __builtin_amdgcn_s_sleep(1); \
    if ((++_sp & 255u) == 0u) { if (xb_ld(&(bar)[XB_TMO])) break; if (_sp > XB_SPIN_CAP) { atomicAdd(&(bar)[XB_TMO], 1u); break; } } } } while (0)

struct XcdBarrier {
    unsigned* bar; unsigned x;
    volatile LAS unsigned* st;
};

__device__ __forceinline__ XcdBarrier xcd_barrier_post(unsigned* bar, volatile LAS unsigned* st) {
    XcdBarrier b; b.bar = bar; b.x = xb_xcc_id(); b.st = st;
    if (threadIdx.x == 0) (void)xb_add(&bar[XB_XCNT(b.x)], 1u);
    return b;
}
__device__ __forceinline__ void xcd_barrier_complete(unsigned* bar, unsigned x, unsigned& nloc, unsigned& nx) {
    const unsigned G = gridDim.x * gridDim.y * gridDim.z;
    unsigned sum, cnt, mine, sp = 0u;
    for (;;) {
        sum = 0u; cnt = 0u; mine = 0u;
#pragma unroll
        for (unsigned j = 0; j < 16; ++j) { const unsigned c = xb_ld(&bar[XB_XCNT(j)]); sum += c; cnt += (c > 0u) ? 1u : 0u; mine = (j == x) ? c : mine; }
        if (sum == G) break;
        __builtin_amdgcn_s_sleep(1);
        if ((++sp & 255u) == 0u) { if (xb_ld(&bar[XB_TMO])) break; if (sp > XB_SPIN_CAP) { atomicAdd(&bar[XB_TMO], 1u); break; } }
    }
    nloc = mine > 0u ? mine : 1u; nx = cnt > 0u ? cnt : 1u;
}

__device__ __forceinline__ void xcd_barrier(const XcdBarrier& b) {
    asm volatile("s_waitcnt vmcnt(0)" ::: "memory");
    __syncthreads();
    if (threadIdx.x == 0) {
        unsigned* bar = b.bar;
        __builtin_amdgcn_s_waitcnt(0);
        unsigned nloc = b.st[0], nx = b.st[1];
        if (nloc == 0u) { xcd_barrier_complete(bar, b.x, nloc, nx); b.st[0] = nloc; b.st[1] = nx; }
        const unsigned old = xb_add(&bar[XB_XSUB(b.x)], 1u);
        const unsigned gen = old / nloc;
        if (old + 1u == (gen + 1u) * nloc) {
            __builtin_amdgcn_fence(__ATOMIC_RELEASE, "agent");
            asm volatile("s_waitcnt vmcnt(0)" ::: "memory");
            const unsigned og = xb_add(&bar[XB_TOP], 1u);
            const unsigned tg = og / nx;
            if (og + 1u == (tg + 1u) * nx) xb_add(&bar[XB_TOPGEN], 1u);
            else XB_SPIN(xb_ld(&bar[XB_TOPGEN]) == tg, bar);
            __builtin_amdgcn_fence(__ATOMIC_ACQUIRE, "agent");
            xb_add(&bar[XB_XGEN(b.x)], 1u);
            asm volatile("s_waitcnt vmcnt(0)" ::: "memory");
        } else {
            XB_SPIN(xb_ld(&bar[XB_XGEN(b.x)]) == gen, bar);
            __builtin_amdgcn_fence(__ATOMIC_ACQUIRE, "agent");
            asm volatile("s_waitcnt vmcnt(0)" ::: "memory");
        }
    }
    __syncthreads();
}


constexpr int P6A_LRU_TILES = 3;
__global__ void __launch_bounds__(512, 2) hawk_hgrn2_fwd(Params P) {
    extern __shared__ __attribute__((aligned(16))) unsigned char lds_raw[];
    LAS unsigned char* lds = (LAS unsigned char*)lds_raw;
    cg::grid_group grid = cg::this_grid();
#define GRID_SYNC() xcd_barrier(xbar_)
#define PHASE_IDS() int tid = threadIdx.x; asm volatile("" : "+v"(tid)); const int lane = tid & 63, wave = __builtin_amdgcn_readfirstlane(tid >> 6); (void)lane; (void)wave
    const int G = gridDim.x;
    volatile LAS unsigned* xst_ = (volatile LAS unsigned*)(lds + (LDS_BYTES - 64));
    if (threadIdx.x < 16) xst_[threadIdx.x] = 0u;
    __syncthreads();
    const XcdBarrier xbar_ = xcd_barrier_post(P.bar, xst_);
    unsigned char* ws = P.ws; unsigned char* ms = ws + WS_MISC;
    bf16* const dH = (bf16*)(ws + WS_H); bf16* const dXA = (bf16*)(ws + WS_XA); bf16* const dGA = (bf16*)(ws + WS_GA); bf16* const dQ = (bf16*)(ws + WS_Q);
    bf16* const dF = (bf16*)(ws + WS_F); bf16* const dI = (bf16*)(ws + WS_I);
    bf16* const dGMA0 = (bf16*)P.out; bf16* const dGMB0 = (bf16*)P.out + (size_t)M * D;
    const bf16* WinT = (const bf16*)(ms + MS_WIN);

    if (P.use_cg_sync) grid.sync();
    { PHASE_IDS(); p0_prologue(P, lds, wave, lane); }
    GRID_SYNC();
    { pg8::Gemm g{dH, WinT, M, 8192, D, D, 0, 0};
      pg8::EpiBf16<2> E{dXA, (size_t)M * D, nullptr, P.b_merge, dGMA0, dGMB0};
      { pg8::StaticOrder S; S.init(M, 8192, G, (int)blockIdx.x); pg8::gemm_phase<pg8::EpiBf16<2>, pg8::StaticOrder, true, true>(lds, g, S, E); }
    }
    GRID_SYNC();
    { const int nh = G / 2;
      PHASE_IDS();
      if ((int)blockIdx.x < nh) {
        for (int it = blockIdx.x; it < NB * NHEAD; it += nh) hgrn_item2(P, lds, it >> 3, it & 7, wave, lane, dQ);
        { __syncthreads();
          if (threadIdx.x == 0) { unsigned* hb = P.bar + 3840 + 16 * ((int)blockIdx.x >> 3); unsigned sp = 0;
              while (__hip_atomic_load(hb, __ATOMIC_RELAXED, __HIP_MEMORY_SCOPE_AGENT) < 8u && ++sp < (1u << 22)) __builtin_amdgcn_s_sleep(2);
              __builtin_amdgcn_fence(__ATOMIC_ACQUIRE, "agent"); asm volatile("s_waitcnt vmcnt(0)" ::: "memory"); }
          __syncthreads(); }
        { pg8::Gemm g{dXA, (const bf16*)(ms + MS_PA), M, D, D, D, 0, 0}; pg8::ColOrder S{(int)blockIdx.x, P6A_LRU_TILES, 4 - P6A_LRU_TILES};
          pg8::EpiGate<0> E{dGMA0, nullptr, dH, P.b_merge};
          pg8::gemm_phase<pg8::EpiGate<0>, pg8::ColOrder, true, true>(lds, g, S, E); } }
      else {
        for (int it = (int)blockIdx.x - nh; it < NB * 8; it += G - nh) lru_item(P, lds, it >> 3, it & 7, wave, lane, dXA);
        { asm volatile("s_waitcnt vmcnt(0) lgkmcnt(0)" ::: "memory"); __syncthreads();
          if (threadIdx.x == 0) { __builtin_amdgcn_fence(__ATOMIC_RELEASE, "agent"); asm volatile("s_waitcnt vmcnt(0)" ::: "memory");
              unsigned* hb = P.bar + 3840 + 16 * (((int)blockIdx.x - nh) >> 3);
              __hip_atomic_fetch_add(hb, 1u, __ATOMIC_RELAXED, __HIP_MEMORY_SCOPE_AGENT);
              unsigned sp = 0; while (__hip_atomic_load(hb, __ATOMIC_RELAXED, __HIP_MEMORY_SCOPE_AGENT) < 8u && ++sp < (1u << 22)) __builtin_amdgcn_s_sleep(2);
              __builtin_amdgcn_fence(__ATOMIC_ACQUIRE, "agent"); asm volatile("s_waitcnt vmcnt(0)" ::: "memory"); }
          __syncthreads(); }
        { pg8::Gemm g{dXA, (const bf16*)(ms + MS_PA), M, D, D, D, 0, 0}; pg8::ColOrder S{(int)blockIdx.x - nh, 0, P6A_LRU_TILES};
          pg8::EpiGate<0> E{dGMA0, nullptr, dH, P.b_merge};
          pg8::gemm_phase<pg8::EpiGate<0>, pg8::ColOrder, true, true>(lds, g, S, E); } } }
    GRID_SYNC();
    { pg8::Gemm g{dQ, (const bf16*)(ms + MS_PB), M, D, D, D, 0, 0}; pg8::PanelOrder S; S.init(M, G, (int)blockIdx.x);
      pg8::EpiGate<1> E{dGMB0, dH, dF, P.b_merge + D};
      pg8::gemm_phase<pg8::EpiGate<1>, pg8::PanelOrder, true, true>(lds, g, S, E); }
    GRID_SYNC();
    { pg8::Gemm g{dF, (const bf16*)(ms + MS_WO), M, D, D, D, 0, 0}; pg8::PanelOrder S; S.init(M, G, (int)blockIdx.x);
      pg8::EpiFinal E{P.x, P.out, P.final_g, (float*)(ms + MS_PART), (unsigned*)(ms + MS_CNT), lds + 131072};
      pg8::gemm_phase<pg8::EpiFinal, pg8::PanelOrder, true, true>(lds, g, S, E); }
}

extern "C" void kernel_launch(void* const* d_in, const int* in_sizes, int n_in, void* d_out, int out_size, void* d_ws, size_t ws_size, hipStream_t stream) {
    static int grid = 0;
    if (!grid) {
        if (n_in != 17 || in_sizes[0] != M * D || out_size != M * D || ws_size < WS_NEED) {
            fprintf(stderr, "kernel_launch: unexpected shapes: n_in %d in0 %d out %d ws %zu (need %zu); nothing launched\n", n_in, n_in > 0 ? in_sizes[0] : -1, out_size, ws_size, (size_t)WS_NEED); grid = -1; return; }
        int dev = 0, cus = 0, per_cu = 0;
        if (hipGetDevice(&dev) != hipSuccess || hipDeviceGetAttribute(&cus, hipDeviceAttributeMultiprocessorCount, dev) != hipSuccess) { grid = -1; return; }
        if (hipFuncSetAttribute((const void*)hawk_hgrn2_fwd, hipFuncAttributeMaxDynamicSharedMemorySize, LDS_BYTES) != hipSuccess) { fprintf(stderr, "kernel_launch: hipFuncSetAttribute failed\n"); grid = -1; return; }
        if (hipOccupancyMaxActiveBlocksPerMultiprocessor(&per_cu, (const void*)hawk_hgrn2_fwd, 512, LDS_BYTES) != hipSuccess || per_cu < 1) { fprintf(stderr, "kernel_launch: occupancy query says %d\n", per_cu); }
        if (cus < 256) { fprintf(stderr, "kernel_launch: this build needs 256 co-resident workgroups (one per CU); the device has %d CUs; nothing launched\n", cus); grid = -1; return; }
        grid = 256;
    }
    if (grid <= 0) return;
    Params p{};
    p.x = (const float*)d_in[0]; p.w_in = (const float*)d_in[1]; p.b_merge = (const float*)d_in[2]; p.conv_w = (const float*)d_in[3]; p.conv_b = (const float*)d_in[4];
    p.rg_wx = (const float*)d_in[5]; p.rg_bx = (const float*)d_in[6]; p.rg_wa = (const float*)d_in[7]; p.rg_ba = (const float*)d_in[8]; p.rg_lambda = (const float*)d_in[9];
    p.hg_lb = (const float*)d_in[10]; p.hg_norm_g = (const float*)d_in[11]; p.proj_a = (const float*)d_in[12]; p.proj_b = (const float*)d_in[13]; p.w_out = (const float*)d_in[14];
    p.norm_g = (const float*)d_in[15]; p.final_g = (const float*)d_in[16];
    p.out = (float*)d_out; p.ws = (unsigned char*)d_ws; p.bar = (unsigned*)((unsigned char*)d_ws + WS_MISC + MS_BAR); p.use_cg_sync = 0; p.pad = 0;
    if (hipMemsetAsync(p.bar, 0, 16384, stream) != hipSuccess) { fprintf(stderr, "kernel_launch: memset failed\n"); return; }
    void* args[] = {&p};
    hipError_t e = hipLaunchCooperativeKernel((const void*)hawk_hgrn2_fwd, dim3(grid), dim3(512), args, LDS_BYTES, stream);
    if (e != hipSuccess) fprintf(stderr, "kernel_launch: cooperative launch failed: %s (grid %d)\n", hipGetErrorString(e), grid);
}
```

```cpp
#include <hip/hip_runtime.h>
#include <hip/hip_cooperative_groups.h>
#include <cstdio>
#include <cstdint>
namespace cg = cooperative_groups;

#ifndef GATE_SIG_IN_S1
#define GATE_SIG_IN_S1 0
#endif
#ifndef S1_SILU
#define S1_SILU 0
#endif
namespace pg8 {
#define PG8_LAS __attribute__((address_space(3)))
typedef unsigned short bf16_t;
typedef short bf16x8 __attribute__((ext_vector_type(8)));
typedef float f32x4 __attribute__((ext_vector_type(4)));
typedef unsigned u32x4 __attribute__((ext_vector_type(4)));
typedef unsigned u32x2 __attribute__((ext_vector_type(2)));
constexpr int BM = 256, BK = 64, HALF = 128, HTB = HALF * BK * 2  , STAGE_BYTES = 8 * HTB, NXCD = 8, WGM = 8;

__host__ __device__ __forceinline__ int lds_byte(int r, int c) { const int st = (r >> 4) * 2 + (c >> 5), rr = r & 15, cc = c & 31, ob = rr * 64 + cc * 2; return st * 1024 + (ob ^ (((ob >> 9) & 1) << 5)); }
__host__ __device__ __forceinline__ void stage_rc(int b, int& R, int& C) { const int st = b / 1024, sb = b % 1024, swz = sb ^ (((sb >> 9) & 1) << 5); R = (st >> 1) * 16 + swz / 64; C = (st & 1) * 32 + (swz % 64) / 2; }
__host__ __device__ __forceinline__ int perm32(int rho) { const int n = rho >> 4, i = rho & 15; return 8 * (i >> 2) + 4 * n + (i & 3); }

struct Unit { int pm, pn; };
struct Gemm { const bf16_t* A; const bf16_t* Bt; int M, N, K, lda, apn_shift, apn_bytes; };

struct StaticOrder {
    int nM, nN, nwg, G, c;
    __host__ __device__ void init(int M, int N, int G_, int c_) { nM = M / BM; nN = N / BM; nwg = nM * nN; G = G_; c = c_; }
    __host__ __device__ bool next(int i, Unit& u) const {
        const long L = (long)i * G + c; if (L >= nwg) return false;
        int wgid = (int)L; { const int q = nwg / NXCD, r = nwg % NXCD, xcd = wgid % NXCD, off = wgid / NXCD; wgid = (xcd < r ? xcd * (q + 1) : r * (q + 1) + (xcd - r) * q) + off; }
        const int nig = WGM * nN, gid = wgid / nig, fm = gid * WGM, gsz = (nM - fm) < WGM ? (nM - fm) : WGM;
        u.pm = fm + ((wgid % nig) % gsz); u.pn = (wgid % nig) / gsz; return true;
    }
    __device__ __forceinline__ void a_ready(const Unit&) const {}
    __device__ __forceinline__ void done(const Unit&) const {}
};

typedef float f32x2_t __attribute__((ext_vector_type(2)));
typedef __bf16 bf16x2_t __attribute__((ext_vector_type(2)));
__device__ __forceinline__ unsigned cvt_pk_bf16(float lo, float hi) { const f32x2_t v = {lo, hi}; const bf16x2_t b = __builtin_convertvector(v, bf16x2_t); return __builtin_bit_cast(unsigned, b); }
struct ColOrder {
    int pm, pn0, npn;
    __host__ __device__ bool next(int i, Unit& u) const { if (i >= npn) return false; u.pm = pm; u.pn = pn0 + i; return true; }
    __device__ __forceinline__ void a_ready(const Unit&) const {}
    __device__ __forceinline__ void done(const Unit&) const {}
};
__device__ __forceinline__ float bf_lo(unsigned w) { return __builtin_bit_cast(float, w << 16); }
__device__ __forceinline__ float bf_hi(unsigned w) { return __builtin_bit_cast(float, w & 0xffff0000u); }
__device__ __forceinline__ float fsigmoid(float x) { return __builtin_amdgcn_rcpf(1.0f + __builtin_amdgcn_exp2f(-1.44269504089f * x)); }
__device__ __forceinline__ u32x4 pack8(f32x4 v0, f32x4 v1) { u32x4 w; w.x = cvt_pk_bf16(v0[0], v0[1]); w.y = cvt_pk_bf16(v0[2], v0[3]); w.z = cvt_pk_bf16(v1[0], v1[1]); w.w = cvt_pk_bf16(v1[2], v1[3]); return w; }
__device__ __forceinline__ void unpack8(u32x4 w, f32x4& v0, f32x4& v1) { v0 = (f32x4){bf_lo(w.x), bf_hi(w.x), bf_lo(w.y), bf_hi(w.y)}; v1 = (f32x4){bf_lo(w.z), bf_hi(w.z), bf_lo(w.w), bf_hi(w.w)}; }

template <int ACT> struct EpiBf16 {
    static constexpr bool PERM = true, AFTER_DRAIN = false;
    bf16_t* O; size_t split_stride; bf16_t* O1; const float* bias; bf16_t* O6; bf16_t* O7;
    __device__ __forceinline__ void operator()(const f32x4 (&acc)[2][2][4][2], const Unit& u, int, int, int, int) const {
        int t_ = threadIdx.x; asm volatile("" : "+v"(t_));
        const int wid_ = t_ >> 6, wr = wid_ >> 2, wc = wid_ & 3, fr = t_ & 15, fq = (t_ >> 4) & 3;
        const int row0 = u.pm * BM + wr * 64 + fr; int colt = u.pn * BM; const int t = colt >> 10; colt &= 1023;
        bf16_t* base = (t == 1 && O1) ? O1 : O + (size_t)t * split_stride;
        if (ACT == 2) { if (t == 6) base = O6; if (t == 7) base = O7; }
        const int col0 = colt + wc * 32 + 8 * fq, bcol0 = u.pn * BM + wc * 32 + 8 * fq - (ACT == 2 ? 6144 : 0);
        const bool has_bias = (ACT == 1) || (ACT == 2 && GATE_SIG_IN_S1 && t >= 6);
        f32x4 bv[2][2];
#pragma unroll
        for (int bj = 0; bj < 2; ++bj)
#pragma unroll
            for (int n = 0; n < 2; ++n) bv[bj][n] = has_bias ? *(const f32x4*)(bias + bcol0 + bj * HALF + 4 * n) : (f32x4){0.f, 0.f, 0.f, 0.f};
#pragma unroll
        for (int ai = 0; ai < 2; ++ai)
#pragma unroll
            for (int m = 0; m < 4; ++m) { bf16_t* rowp = base + (size_t)(row0 + ai * HALF + m * 16) * 1024 + col0;
#pragma unroll
                for (int bj = 0; bj < 2; ++bj) { f32x4 v0 = acc[ai][bj][m][0] + bv[bj][0], v1 = acc[ai][bj][m][1] + bv[bj][1];
                    if (ACT == 1) {
#pragma unroll
                        for (int i = 0; i < 4; ++i) { v0[i] = fsigmoid(v0[i]); v1[i] = fsigmoid(v1[i]); } }
                    if (ACT == 2) { if (GATE_SIG_IN_S1 && t >= 6) {
#pragma unroll
                        for (int i = 0; i < 4; ++i) { v0[i] = fsigmoid(v0[i]); v1[i] = fsigmoid(v1[i]); } }
                      if (S1_SILU && (t == 2 || t == 5)) { const float sc = (t == 2) ? 0.08838834764831845f : 1.0f;
#pragma unroll
                        for (int i = 0; i < 4; ++i) { v0[i] = v0[i] * fsigmoid(v0[i]) * sc; v1[i] = v1[i] * fsigmoid(v1[i]) * sc; } } }
                    if (ACT == 2) __builtin_nontemporal_store(pack8(v0, v1), (u32x4*)(rowp + bj * HALF));
                    else *(u32x4*)(rowp + bj * HALF) = pack8(v0, v1); } }
    }
};
template <int MODE> struct EpiGate {
    static constexpr bool PERM = true, AFTER_DRAIN = false;
    const bf16_t* G; const bf16_t* T; bf16_t* O; const float* gbias;
    __device__ __forceinline__ void operator()(const f32x4 (&acc)[2][2][4][2], const Unit& u, int, int, int, int) const {
        int t_ = threadIdx.x; asm volatile("" : "+v"(t_));
        const int wid_ = t_ >> 6, wr = wid_ >> 2, wc = wid_ & 3, fr = t_ & 15, fq = (t_ >> 4) & 3;
        const int row0 = u.pm * BM + wr * 64 + fr, col0 = u.pn * BM + wc * 32 + 8 * fq;
        f32x4 gb_[2][2];
#pragma unroll
        for (int bj = 0; bj < 2; ++bj)
#pragma unroll
            for (int n = 0; n < 2; ++n) gb_[bj][n] = GATE_SIG_IN_S1 ? (f32x4){0.f, 0.f, 0.f, 0.f} : *(const f32x4*)(gbias + col0 + bj * HALF + 4 * n);
#pragma unroll
        for (int ai = 0; ai < 2; ++ai)
#pragma unroll
            for (int m = 0; m < 4; ++m) { const size_t ro = (size_t)(row0 + ai * HALF + m * 16) * 1024 + col0;
#pragma unroll
                for (int bj = 0; bj < 2; ++bj) {
                    f32x4 g0, g1; unpack8(__builtin_nontemporal_load((const u32x4*)(G + ro + bj * HALF)), g0, g1);
                    if (!GATE_SIG_IN_S1) {
#pragma unroll
                        for (int i = 0; i < 4; ++i) { g0[i] = fsigmoid(g0[i] + gb_[bj][0][i]); g1[i] = fsigmoid(g1[i] + gb_[bj][1][i]); } }
                    f32x4 v0 = acc[ai][bj][m][0] * g0, v1 = acc[ai][bj][m][1] * g1;
                    if (MODE == 1) { f32x4 t0, t1; unpack8(__builtin_nontemporal_load((const u32x4*)(T + ro + bj * HALF)), t0, t1); v0 = v0 + t0; v1 = v1 + t1; }
                    *(u32x4*)(O + ro + bj * HALF) = pack8(v0, v1); } }
    }
};
struct EpiResid {
    static constexpr bool PERM = true, AFTER_DRAIN = false;
    const float* X; float* O;
    __device__ __forceinline__ void operator()(const f32x4 (&acc)[2][2][4][2], const Unit& u, int, int, int, int) const {
        int t_ = threadIdx.x; asm volatile("" : "+v"(t_));
        const int wid_ = t_ >> 6, wr = wid_ >> 2, wc = wid_ & 3, fr = t_ & 15, fq = (t_ >> 4) & 3;
        const int row0 = u.pm * BM + wr * 64 + fr, col0 = u.pn * BM + wc * 32 + 8 * fq;
#pragma unroll
        for (int ai = 0; ai < 2; ++ai)
#pragma unroll
            for (int m = 0; m < 4; ++m) { const size_t ro = (size_t)(row0 + ai * HALF + m * 16) * 1024 + col0;
#pragma unroll
                for (int bj = 0; bj < 2; ++bj) {
                    const f32x4 x0 = *(const f32x4*)(X + ro + bj * HALF), x1 = *(const f32x4*)(X + ro + bj * HALF + 4);
                    *(f32x4*)(O + ro + bj * HALF) = x0 + acc[ai][bj][m][0]; *(f32x4*)(O + ro + bj * HALF + 4) = x1 + acc[ai][bj][m][1]; } }
    }
};

struct PanelOrder {
    int nwg, G, c;
    __host__ __device__ void init(int M, int G_, int c_) { nwg = (M / BM) * 4; G = G_; c = c_; }
    __host__ __device__ bool next(int i, Unit& u) const { const long L = (long)i * G + c; if (L >= nwg) return false;
        if ((G & 31) != 0) { u.pm = (int)(L >> 2); u.pn = (int)(L & 3); return true; }
        const int x = c & 7, k = c >> 3; u.pn = k & 3; u.pm = i * (G >> 2) + (k >> 2) * 8 + x; return true; }
    __device__ __forceinline__ void a_ready(const Unit&) const {}
    __device__ __forceinline__ void done(const Unit&) const {}
};
struct EpiFinal {
    static constexpr bool PERM = true, AFTER_DRAIN = false;
    const float* X; float* O; const float* gain; float* part; unsigned* cnt; PG8_LAS unsigned char* scr;
    __device__ __forceinline__ void operator()(f32x4 (&acc)[2][2][4][2], const Unit& u, int, int, int, int) const {
        int t_ = threadIdx.x; asm volatile("" : "+v"(t_));
        const int wid_ = t_ >> 6, wr = wid_ >> 2, wc = wid_ & 3, fr = t_ & 15, fq = (t_ >> 4) & 3;
        const int row0 = u.pm * BM + wr * 64 + fr, col0 = u.pn * BM + wc * 32 + 8 * fq;
        PG8_LAS float* ssl = (PG8_LAS float*)scr; PG8_LAS float* rstd_l = (PG8_LAS float*)(scr + 4096);
#pragma unroll
        for (int ai = 0; ai < 2; ++ai)
#pragma unroll
            for (int m = 0; m < 4; ++m) { const size_t ro = (size_t)(row0 + ai * HALF + m * 16) * 1024 + col0; float s = 0.f;
#pragma unroll
                for (int bj = 0; bj < 2; ++bj) {
                    const f32x4 x0 = __builtin_nontemporal_load((const f32x4*)(X + ro + bj * HALF)), x1 = __builtin_nontemporal_load((const f32x4*)(X + ro + bj * HALF + 4));
                    acc[ai][bj][m][0] = acc[ai][bj][m][0] + x0; acc[ai][bj][m][1] = acc[ai][bj][m][1] + x1;
#pragma unroll
                    for (int n = 0; n < 2; ++n) { const f32x4 v = acc[ai][bj][m][n]; s += (v[0] * v[0] + v[1] * v[1]) + (v[2] * v[2] + v[3] * v[3]); } }
                s += __shfl_xor(s, 16); s += __shfl_xor(s, 32);
                if (fq == 0) ssl[((wr * 4 + wc) * 8 + ai * 4 + m) * 16 + fr] = s; }
        asm volatile("s_waitcnt lgkmcnt(0)" ::: "memory"); __builtin_amdgcn_s_barrier(); asm volatile("" ::: "memory");
        const int rr = t_ & 255, r_ai = rr >> 7, r_wr = (rr >> 6) & 1, r_m = (rr >> 4) & 3, r_fr = rr & 15;
        if (t_ < 256) { float s = 0.f;
#pragma unroll
            for (int c = 0; c < 4; ++c) s += ssl[((r_wr * 4 + c) * 8 + r_ai * 4 + r_m) * 16 + r_fr];
            __hip_atomic_store(part + (size_t)(u.pm * 4 + u.pn) * 256 + rr, s, __ATOMIC_RELAXED, __HIP_MEMORY_SCOPE_AGENT);
            asm volatile("s_waitcnt vmcnt(0)" ::: "memory"); }
        asm volatile("s_waitcnt lgkmcnt(0)" ::: "memory"); __builtin_amdgcn_s_barrier(); asm volatile("" ::: "memory");
        if (t_ == 0) { __hip_atomic_fetch_add(cnt + u.pm, 1u, __ATOMIC_RELAXED, __HIP_MEMORY_SCOPE_AGENT);
            unsigned sp = 0; while (__hip_atomic_load(cnt + u.pm, __ATOMIC_RELAXED, __HIP_MEMORY_SCOPE_AGENT) < 4u && ++sp < (1u << 22)) __builtin_amdgcn_s_sleep(2); }
        asm volatile("s_waitcnt vmcnt(0) lgkmcnt(0)" ::: "memory"); __builtin_amdgcn_s_barrier(); asm volatile("" ::: "memory");
        if (t_ < 256) { float s = 0.f;
#pragma unroll
            for (int c = 0; c < 4; ++c) s += __hip_atomic_load(part + (size_t)(u.pm * 4 + c) * 256 + rr, __ATOMIC_RELAXED, __HIP_MEMORY_SCOPE_AGENT);
            rstd_l[rr] = 1.0f / sqrtf(s * (1.0f / 1024.0f) + 1e-6f); }
        asm volatile("s_waitcnt vmcnt(0) lgkmcnt(0)" ::: "memory"); __builtin_amdgcn_s_barrier(); asm volatile("" ::: "memory");
        f32x4 gv[2][2];
#pragma unroll
        for (int bj = 0; bj < 2; ++bj)
#pragma unroll
            for (int n = 0; n < 2; ++n) gv[bj][n] = *(const f32x4*)(gain + col0 + bj * HALF + 4 * n);
#pragma unroll
        for (int ai = 0; ai < 2; ++ai)
#pragma unroll
            for (int m = 0; m < 4; ++m) { const size_t ro = (size_t)(row0 + ai * HALF + m * 16) * 1024 + col0; const float rs = rstd_l[ai * 128 + wr * 64 + m * 16 + fr];
#pragma unroll
                for (int bj = 0; bj < 2; ++bj) { *(f32x4*)(O + ro + bj * HALF) = (acc[ai][bj][m][0] * rs) * gv[bj][0]; *(f32x4*)(O + ro + bj * HALF + 4) = (acc[ai][bj][m][1] * rs) * gv[bj][1]; } }
        asm volatile("s_waitcnt lgkmcnt(0)" ::: "memory");
    }
};


template <class Epi, class Sched, bool ALIGN_EPI = false, bool SP2 = false>
__device__ __forceinline__ void gemm_phase(PG8_LAS unsigned char* lds, const Gemm g, const Sched& S, const Epi& E) {
    int tid = threadIdx.x; asm volatile("" : "+v"(tid));
    const int wid = __builtin_amdgcn_readfirstlane(tid >> 6), lane = tid & 63, wr = wid >> 2, wc = wid & 3, fr = lane & 15, fq = lane >> 4;
    int K = g.K; asm volatile("" : "+s"(K)); const int nt = K / BK;
    unsigned voffA[2], voffB[2];
#pragma unroll
    for (int i = 0; i < 2; ++i) { int R, C; stage_rc(tid * 16 + i * 8192, R, C); const int Rb = Epi::PERM ? ((R & ~31) + perm32(R & 31)) : R;
        voffA[i] = (unsigned)(R * g.lda + C) * 2u; voffB[i] = (unsigned)(Rb * K + C) * 2u; }
    const size_t kstep = (size_t)(BK * 2);
    const size_t hstepB = (size_t)HALF * K * 2, hstepA = (size_t)HALF * g.lda * 2;
    const size_t tstepB = 2 * hstepB, tstepA = 2 * hstepA;
    const unsigned ldsw = (unsigned)wid * 1024u;
    const int aoff = lds_byte(wr * 64 + fr, fq * 8), boff = lds_byte(wc * 32 + fr, fq * 8);
#define PG8_SA(b, h) (((b) * 2 + (h)) * HTB)
#define PG8_SB(b, h) ((4 + (b) * 2 + (h)) * HTB)
#define PG8_STAGE(bufoff, gbase, voff) do { _Pragma("unroll") for (int _i = 0; _i < 2; ++_i) \
        __builtin_amdgcn_global_load_lds((const unsigned*)((const char*)(gbase) + (voff)[_i]), (PG8_LAS unsigned*)(lds + (bufoff) + ldsw + _i * 8192), 16, 0, 0); } while (0)
#define PG8_LDA(dst, b, h) do { _Pragma("unroll") for (int m = 0; m < 4; ++m) _Pragma("unroll") for (int k = 0; k < 2; ++k) dst[m][k] = *(const PG8_LAS bf16x8*)(lds + PG8_SA(b, h) + aoff + m * 2048 + k * 1024); } while (0)
#define PG8_LDB(dst, b, h) do { _Pragma("unroll") for (int n = 0; n < 2; ++n) _Pragma("unroll") for (int k = 0; k < 2; ++k) dst[n][k] = *(const PG8_LAS bf16x8*)(lds + PG8_SB(b, h) + boff + n * 2048 + k * 1024); } while (0)
#define PG8_MMA(ai, bj, At, Bt) do { __builtin_amdgcn_s_setprio(1); _Pragma("unroll") for (int m = 0; m < 4; ++m) _Pragma("unroll") for (int n = 0; n < 2; ++n) _Pragma("unroll") for (int k = 0; k < 2; ++k) \
        acc[ai][bj][m][n] = __builtin_amdgcn_mfma_f32_16x16x32_bf16(Bt[n][k], At[m][k], acc[ai][bj][m][n], 0, 0, 0); __builtin_amdgcn_s_setprio(0); } while (0)
#define PG8_WAIT_V(n) asm volatile("s_waitcnt vmcnt(" #n ")" ::: "memory")
#define PG8_WAIT_L(n) asm volatile("s_waitcnt lgkmcnt(" #n ")" ::: "memory")
#define PG8_BAR __builtin_amdgcn_s_barrier()
#define PG8_SCHED __builtin_amdgcn_sched_barrier(0)
    Unit cur, nxt; int ui = 0;
    if (!S.next(0, cur)) return;
    f32x4 acc[2][2][4][2];
#pragma unroll
    for (int a = 0; a < 2; ++a)
#pragma unroll
        for (int b = 0; b < 2; ++b)
#pragma unroll
            for (int m = 0; m < 4; ++m)
#pragma unroll
                for (int n = 0; n < 2; ++n) acc[a][b][m][n] = (f32x4){0.f, 0.f, 0.f, 0.f};
    bf16x8 At[4][2], B0[2][2], B1[2][2];
    const char* cA = (const char*)g.A + (size_t)cur.pm * tstepA + (size_t)(cur.pn >> g.apn_shift) * g.apn_bytes; const char* cB = (const char*)g.Bt + (size_t)cur.pn * tstepB;
    S.a_ready(cur);
    if constexpr (SP2) {
        PG8_STAGE(PG8_SB(0, 0), cB, voffB); PG8_STAGE(PG8_SB(0, 1), cB + hstepB, voffB); PG8_STAGE(PG8_SA(0, 0), cA, voffA); PG8_STAGE(PG8_SA(0, 1), cA + hstepA, voffA);
        if (wr == 1) PG8_BAR;
        PG8_WAIT_V(2); PG8_BAR;
        PG8_STAGE(PG8_SB(1, 0), cB + kstep, voffB); PG8_STAGE(PG8_SA(1, 0), cA + kstep, voffA); PG8_STAGE(PG8_SB(1, 1), cB + hstepB + kstep, voffB);
        PG8_WAIT_V(6); PG8_BAR;
    } else {
        PG8_STAGE(PG8_SB(0, 0), cB, voffB); PG8_STAGE(PG8_SA(0, 0), cA, voffA); PG8_STAGE(PG8_SB(0, 1), cB + hstepB, voffB); PG8_STAGE(PG8_SA(0, 1), cA + hstepA, voffA);
        if (wr == 1) PG8_BAR;
        PG8_WAIT_V(4); PG8_BAR;
        PG8_STAGE(PG8_SB(1, 0), cB + kstep, voffB); PG8_STAGE(PG8_SA(1, 0), cA + kstep, voffA); PG8_STAGE(PG8_SB(1, 1), cB + hstepB + kstep, voffB);
        PG8_WAIT_V(6); PG8_BAR;
    }
    for (;;) {
        const bool has_next = S.next(ui + 1, nxt);
        const char* nA = has_next ? (const char*)g.A + (size_t)nxt.pm * tstepA + (size_t)(nxt.pn >> g.apn_shift) * g.apn_bytes : cA; const char* nB = has_next ? (const char*)g.Bt + (size_t)nxt.pn * tstepB : cB;
        for (int t = 0; t < nt; t += 2) {
            const bool last = (t == nt - 2);
            const char* a1 = cA + (size_t)(t + 1) * kstep;
            const char* a2 = last ? nA : cA + (size_t)(t + 2) * kstep; const char* b2 = last ? nB : cB + (size_t)(t + 2) * kstep;
            const char* a3 = a2 + kstep; const char* b3 = b2 + kstep;
            if (last && has_next) S.a_ready(nxt);
            if constexpr (SP2) {
            PG8_LDB(B0, 0, 0); PG8_LDB(B1, 0, 1); PG8_SCHED; PG8_LDA(At, 0, 0); PG8_STAGE(PG8_SA(1, 1), a1 + hstepA, voffA);
            PG8_WAIT_V(8); PG8_WAIT_L(0); PG8_BAR; PG8_MMA(0, 0, At, B0); PG8_MMA(0, 1, At, B1); PG8_BAR; PG8_SCHED;
            PG8_LDA(At, 0, 1); PG8_STAGE(PG8_SB(0, 0), b2, voffB); PG8_STAGE(PG8_SB(0, 1), b2 + hstepB, voffB); PG8_STAGE(PG8_SA(0, 0), a2, voffA);
            PG8_WAIT_V(8); PG8_WAIT_L(0); PG8_BAR; PG8_MMA(1, 0, At, B0); PG8_MMA(1, 1, At, B1); PG8_BAR; PG8_SCHED;
            PG8_LDB(B0, 1, 0); PG8_LDB(B1, 1, 1); PG8_SCHED; PG8_LDA(At, 1, 0); PG8_STAGE(PG8_SA(0, 1), a2 + hstepA, voffA);
            PG8_WAIT_V(8); PG8_WAIT_L(0); PG8_BAR; PG8_MMA(0, 0, At, B0); PG8_MMA(0, 1, At, B1); PG8_BAR; PG8_SCHED;
            PG8_LDA(At, 1, 1); PG8_STAGE(PG8_SB(1, 0), b3, voffB); PG8_STAGE(PG8_SB(1, 1), b3 + hstepB, voffB); PG8_STAGE(PG8_SA(1, 0), a3, voffA);
            PG8_WAIT_V(8); PG8_WAIT_L(0); PG8_BAR; PG8_MMA(1, 0, At, B0); PG8_MMA(1, 1, At, B1); PG8_BAR; PG8_SCHED;
            } else {
            PG8_LDB(B0, 0, 0); PG8_SCHED; PG8_LDA(At, 0, 0); PG8_STAGE(PG8_SA(1, 1), a1 + hstepA, voffA);
            PG8_WAIT_L(8); PG8_BAR; PG8_WAIT_L(0); PG8_MMA(0, 0, At, B0); PG8_BAR; PG8_SCHED;
            PG8_LDB(B1, 0, 1); PG8_STAGE(PG8_SB(0, 0), b2, voffB);
            PG8_BAR; PG8_WAIT_L(0); PG8_MMA(0, 1, At, B1); PG8_BAR;
            PG8_LDA(At, 0, 1); PG8_STAGE(PG8_SA(0, 0), a2, voffA);
            PG8_BAR; PG8_WAIT_L(0); PG8_MMA(1, 0, At, B0); PG8_BAR; PG8_SCHED;
            PG8_STAGE(PG8_SB(0, 1), b2 + hstepB, voffB);
            PG8_WAIT_V(6); PG8_BAR; PG8_MMA(1, 1, At, B1); PG8_BAR;
            PG8_LDB(B0, 1, 0); PG8_SCHED; PG8_LDA(At, 1, 0); PG8_STAGE(PG8_SA(0, 1), a2 + hstepA, voffA);
            PG8_WAIT_L(8); PG8_BAR; PG8_WAIT_L(0); PG8_MMA(0, 0, At, B0); PG8_BAR; PG8_SCHED;
            PG8_LDB(B1, 1, 1); PG8_STAGE(PG8_SB(1, 0), b3, voffB);
            PG8_BAR; PG8_WAIT_L(0); PG8_MMA(0, 1, At, B1); PG8_BAR;
            PG8_LDA(At, 1, 1); PG8_STAGE(PG8_SA(1, 0), a3, voffA);
            PG8_BAR; PG8_WAIT_L(0); PG8_MMA(1, 0, At, B0); PG8_BAR; PG8_SCHED;
            PG8_STAGE(PG8_SB(1, 1), b3 + hstepB, voffB);
            PG8_WAIT_V(6); PG8_BAR; PG8_MMA(1, 1, At, B1); PG8_BAR;
            }
        }
        if constexpr (ALIGN_EPI) { if (wr == 0) PG8_BAR; }
        if constexpr (!Epi::AFTER_DRAIN) { E(acc, cur, wr, wc, fr, fq); S.done(cur); }
        if (!has_next) break;
#pragma unroll
        for (int a = 0; a < 2; ++a)
#pragma unroll
            for (int b = 0; b < 2; ++b)
#pragma unroll
                for (int m = 0; m < 4; ++m)
#pragma unroll
                    for (int n = 0; n < 2; ++n) acc[a][b][m][n] = (f32x4){0.f, 0.f, 0.f, 0.f};
        cur = nxt; cA = nA; cB = nB; ++ui;
        if constexpr (ALIGN_EPI) { if (wr == 1) PG8_BAR; }
    }
    PG8_WAIT_V(0);
    if constexpr (!ALIGN_EPI) { if (wr == 0) PG8_BAR; }
    PG8_BAR;
    if constexpr (Epi::AFTER_DRAIN) { E.fused(acc, cur, wr, wc, fr, fq, lds, wid, lane); S.done(cur); }
#undef PG8_SA
#undef PG8_SB
#undef PG8_STAGE
#undef PG8_LDA
#undef PG8_LDB
#undef PG8_MMA
#undef PG8_WAIT_V
#undef PG8_WAIT_L
#undef PG8_BAR
#undef PG8_SCHED
}
}

#define LAS __attribute__((address_space(3)))
typedef unsigned short bf16;
typedef pg8::f32x4 f32x4;
typedef pg8::u32x4 u32x4;
typedef pg8::u32x2 u32x2;
typedef float f32x2 __attribute__((ext_vector_type(2)));
typedef pg8::bf16x8 bf16x8;
using pg8::cvt_pk_bf16; using pg8::bf_lo; using pg8::bf_hi; using pg8::fsigmoid;

constexpr int M = 32768, D = 1024, SEQ = 2048, NB = 16, NHEAD = 8;
constexpr int ZCOLS = 6144;
constexpr size_t SLOT = (size_t)M * D * 2;
constexpr size_t WS_H = 0 * SLOT, WS_XA = 1 * SLOT, WS_GA = 2 * SLOT, WS_Q = 3 * SLOT, WS_F = 4 * SLOT, WS_I = 5 * SLOT, WS_GB = 6 * SLOT, WS_MISC = 7 * SLOT;
constexpr size_t MS_WIN = 0, MS_PA = (size_t)16 << 20, MS_PB = (size_t)18 << 20, MS_WO = (size_t)20 << 20, MS_GBT = (size_t)22 << 20, MS_SP8 = (size_t)23 << 20, MS_BAR = ((size_t)23 << 20) + 4096, MS_CNT = MS_BAR + 14336, MS_PART = (size_t)24 << 20, MS_END = ((size_t)24 << 20) + ((size_t)1 << 20);
constexpr size_t WS_NEED = WS_MISC + MS_END;
constexpr int LDS_BYTES = 144 * 1024;
constexpr float EPS = 1e-6f;
constexpr float L2E = 1.44269504089f;

__device__ __forceinline__ float wave_sum(float v) {
#pragma unroll
    for (int o = 1; o < 64; o <<= 1) v += __shfl_xor(v, o);
    return v;
}
__device__ __forceinline__ float fsilu(float x) { return x * fsigmoid(x); }

__device__ __forceinline__ void p0_transpose_item(const float* W, int K, int N, bf16* WT, LAS float* scr, int item, int lane) {
    const int nblk = N / 32, kb = item / nblk, nb = item % nblk, k0 = 64 * kb, n0 = 32 * nb;
#pragma unroll 8
    for (int i = 0; i < 32; ++i) { const int kk = 2 * i + (lane >> 5); scr[kk * 33 + (lane & 31)] = __builtin_nontemporal_load(W + (size_t)(k0 + kk) * N + n0 + (lane & 31)); }
    asm volatile("s_waitcnt lgkmcnt(0)" ::: "memory");
    const int c = lane & 7;
#pragma unroll
    for (int j = 0; j < 4; ++j) { const int n = (lane >> 3) + 8 * j; const LAS float* s = scr + (8 * c) * 33 + n;
        u32x4 o; o.x = cvt_pk_bf16(s[0 * 33], s[1 * 33]); o.y = cvt_pk_bf16(s[2 * 33], s[3 * 33]); o.z = cvt_pk_bf16(s[4 * 33], s[5 * 33]); o.w = cvt_pk_bf16(s[6 * 33], s[7 * 33]);
        *(u32x4*)(WT + (size_t)(n0 + n) * K + k0 + 8 * c) = o; }
    asm volatile("s_waitcnt lgkmcnt(0)" ::: "memory");
}
template <int NR> __device__ __forceinline__ void rms_rows_to_bf16(const float* X, const float* g, bf16* O, int m0, int stride, int lane) {
    f32x4 v[NR][4]; float s[NR];
#pragma unroll
    for (int r = 0; r < NR; ++r) { const f32x4* xr = (const f32x4*)(X + (size_t)(m0 + r * stride) * D) + lane;
#pragma unroll
        for (int j = 0; j < 4; ++j) v[r][j] = __builtin_nontemporal_load(xr + 64 * j); }
    f32x4 gg[4];
#pragma unroll
    for (int j = 0; j < 4; ++j) gg[j] = ((const f32x4*)g + lane)[64 * j];
#pragma unroll
    for (int r = 0; r < NR; ++r) { float a = 0.f;
#pragma unroll
        for (int j = 0; j < 4; ++j) a += (v[r][j].x * v[r][j].x + v[r][j].y * v[r][j].y) + (v[r][j].z * v[r][j].z + v[r][j].w * v[r][j].w);
        s[r] = a; }
#pragma unroll
    for (int o = 1; o < 64; o <<= 1) {
#pragma unroll
        for (int r = 0; r < NR; ++r) s[r] += __shfl_xor(s[r], o); }
#pragma unroll
    for (int r = 0; r < NR; ++r) { const float rstd = 1.0f / sqrtf(s[r] * (1.f / D) + EPS); u32x2* o8 = (u32x2*)(O + (size_t)(m0 + r * stride) * D) + lane;
#pragma unroll
        for (int j = 0; j < 4; ++j) { u32x2 o; o.x = cvt_pk_bf16(v[r][j].x * rstd * gg[j].x, v[r][j].y * rstd * gg[j].y); o.y = cvt_pk_bf16(v[r][j].z * rstd * gg[j].z, v[r][j].w * rstd * gg[j].w); o8[64 * j] = o; } }
}
template <int NR> __device__ __forceinline__ void rms_rows_inplace(float* X, const float* g, int m0, int stride, int lane) {
    f32x4 v[NR][4]; float s[NR];
#pragma unroll
    for (int r = 0; r < NR; ++r) { const f32x4* xr = (const f32x4*)(X + (size_t)(m0 + r * stride) * D) + lane;
#pragma unroll
        for (int j = 0; j < 4; ++j) v[r][j] = xr[64 * j]; }
    f32x4 gg[4];
#pragma unroll
    for (int j = 0; j < 4; ++j) gg[j] = ((const f32x4*)g + lane)[64 * j];
#pragma unroll
    for (int r = 0; r < NR; ++r) { float a = 0.f;
#pragma unroll
        for (int j = 0; j < 4; ++j) a += (v[r][j].x * v[r][j].x + v[r][j].y * v[r][j].y) + (v[r][j].z * v[r][j].z + v[r][j].w * v[r][j].w);
        s[r] = a; }
#pragma unroll
    for (int o = 1; o < 64; o <<= 1) {
#pragma unroll
        for (int r = 0; r < NR; ++r) s[r] += __shfl_xor(s[r], o); }
#pragma unroll
    for (int r = 0; r < NR; ++r) { const float rstd = 1.0f / sqrtf(s[r] * (1.f / D) + EPS); f32x4* xr = (f32x4*)(X + (size_t)(m0 + r * stride) * D) + lane;
#pragma unroll
        for (int j = 0; j < 4; ++j) xr[64 * j] = (v[r][j] * rstd) * gg[j]; }
}

struct Params {
    const float *x, *w_in, *b_merge, *conv_w, *conv_b, *rg_wx, *rg_bx, *rg_wa, *rg_ba, *rg_lambda, *hg_lb, *hg_norm_g, *proj_a, *proj_b, *w_out, *norm_g, *final_g;
    float* out; unsigned char* ws; unsigned* bar; int use_cg_sync; int pad;
};

__device__ __forceinline__ void p0_prologue(const Params& P, LAS unsigned char* lds, int wave, int lane) {
    unsigned char* ms = P.ws + WS_MISC;
    LAS float* scr = (LAS float*)(lds + wave * 16384);
    const int G = gridDim.x, gw = blockIdx.x * 8 + wave, NGW = G * 8;
    constexpr int I_IN = (D / 64) * (8192 / 32), I_P = (D / 64) * (D / 32);
    for (int it = gw; it < I_IN + 3 * I_P; it += NGW) {
        int r = it;
        if (r < I_IN) { p0_transpose_item(P.w_in, D, 8192, (bf16*)(ms + MS_WIN), scr, r, lane); continue; } r -= I_IN;
        if (r < I_P) { p0_transpose_item(P.proj_a, D, D, (bf16*)(ms + MS_PA), scr, r, lane); continue; } r -= I_P;
        if (r < I_P) { p0_transpose_item(P.proj_b, D, D, (bf16*)(ms + MS_PB), scr, r, lane); continue; } r -= I_P;
        p0_transpose_item(P.w_out, D, D, (bf16*)(ms + MS_WO), scr, r, lane);
    }
    { bf16* GB = (bf16*)(ms + MS_GBT); const int gt = blockIdx.x * 512 + wave * 64 + lane, GT = G * 512;
      for (int e = gt; e < 2048 * 256; e += GT) { const int cl = e & 127, k = (e >> 7) & 255, gate = (e >> 15) & 1, blk = e >> 16;
          const int kin = k - 128 * (blk & 1); float v = 0.f;
          if (kin >= 0 && kin < 128) v = (gate ? P.rg_wa : P.rg_wx)[((size_t)blk * 128 + kin) * 128 + cl];
          GB[(size_t)(256 * blk + 128 * gate + cl) * 256 + k] = (bf16)(cvt_pk_bf16(v, 0.f) & 0xffffu); }
      float* sp8 = (float*)(ms + MS_SP8);
      for (int e = gt; e < D; e += GT) sp8[e] = 8.0f * log1pf(expf(-P.rg_lambda[e])); }
    bf16* H = (bf16*)(P.ws + WS_H);
    for (int m = gw; m < M; m += 4 * NGW) rms_rows_to_bf16<4>(P.x, P.norm_g, H, m, NGW, lane);
}

constexpr int HG_QIN = 0, HG_KIN = 17408, HG_QINT = 34816, HG_KST = 52224, HG_VT = 70656, HG_ATT = 89088, HG_ST = 98304, HG_TOT = 133120, HG_LF = 137216, HG_DEC = 137728, HG_SSQ = 138240;
__device__ __forceinline__ bf16x8 lds_frag(LAS unsigned char* p) { return *(const LAS bf16x8*)p; }

#define HG_PREP1(NXT_ROW)                                                                                                   \
    _Pragma("unroll") for (int tt = 0; tt < 8; ++tt) { _Pragma("unroll") for (int c = 0; c < 2; ++c) {                     \
        const float fp = c ? bf_hi(rf[tt]) : bf_lo(rf[tt]);                                                                 \
        { const float qv_ = c ? bf_hi(rq[tt]) : bf_lo(rq[tt]); qh[tt][c] = S1_SILU ? qv_ : fsilu(qv_) * 0.08838834764831845f; } vv[tt][c] = c ? bf_hi(ri[tt]) : bf_lo(ri[tt]); \
        const float sg = fsigmoid(fp), f = lb[c] + (1.0f - lb[c]) * sg;                                                     \
        kk[tt][c] = (1.0f - lb[c]) * (1.0f - sg); pf[tt][c] = tt ? f * pf[tt - 1][c] : f; } }                               \
    *(LAS f32x2*)(lds + HG_TOT + (w * 128 + d0) * 4) = (f32x2){pf[7][0], pf[7][1]};                                         \
    if (w == 4) *(LAS f32x2*)(lds + HG_LF + d0 * 4) = (f32x2){pf[0][0], pf[0][1]};                                          \
    { const size_t nr_ = ((NXT_ROW) < row0 + SEQ) ? (NXT_ROW) : row0 + SEQ - 64;     \
      _Pragma("unroll") for (int tt = 0; tt < 8; ++tt) { const size_t o = (nr_ + w * 8 + tt) * D + colq; \
        rq[tt] = __builtin_nontemporal_load((const unsigned*)(Qs + o)); rf[tt] = __builtin_nontemporal_load((const unsigned*)(Fs + o)); ri[tt] = __builtin_nontemporal_load((const unsigned*)(Is + o)); } }
__device__ __forceinline__ void hgrn_item2(const Params& P, LAS unsigned char* lds, int b, int hd, int w, int l, bf16* YB) {
    const bf16* Qs = (const bf16*)(P.ws + WS_Q); const bf16* Fs = (const bf16*)(P.ws + WS_F); const bf16* Is = (const bf16*)(P.ws + WS_I); const bf16* GBs = (const bf16*)(P.ws + WS_GB);
    const int fr = l & 15, fq = l >> 4, ti = w >> 1, wh = w & 1, th = w >> 2, vq = w & 3;
    const int d0 = 2 * l;
    float lb[2];
#pragma unroll
    for (int c = 0; c < 2; ++c) { const float l0 = P.hg_lb[hd * 128 + d0 + c], l1 = P.hg_lb[D + hd * 128 + d0 + c]; lb[c] = 1.0f / (1.0f + expf(l1 - l0)); }
    f32x4 gn[2];
#pragma unroll
    for (int vv2 = 0; vv2 < 2; ++vv2) gn[vv2] = *(const f32x4*)(P.hg_norm_g + 16 * (2 * vq + vv2) + 4 * fq);
    f32x4 S[4][2];
#pragma unroll
    for (int i = 0; i < 4; ++i) { S[i][0] = (f32x4){0.f, 0.f, 0.f, 0.f}; S[i][1] = S[i][0]; }
    __syncthreads();
    for (int e = w * 64 + l; e < 34816 / 4; e += 512) ((LAS unsigned*)(lds + HG_ST))[e] = 0u;
    const size_t row0 = (size_t)b * SEQ;
    const int colq = hd * 128 + d0;
    unsigned rq[8], rf[8], ri[8];
#pragma unroll
    for (int tt = 0; tt < 8; ++tt) { const size_t o = (row0 + w * 8 + tt) * D + colq; rq[tt] = __builtin_nontemporal_load((const unsigned*)(Qs + o)); rf[tt] = __builtin_nontemporal_load((const unsigned*)(Fs + o)); ri[tt] = __builtin_nontemporal_load((const unsigned*)(Is + o)); }
    float qh[8][2], kk[8][2], pf[8][2], vv[8][2];
    HG_PREP1(row0 + 64)
    __syncthreads();
    for (int n = 0; n < 32; ++n) {
        const size_t crow = row0 + (size_t)n * 64;
        u32x2 gbv[2][2];
#pragma unroll
        for (int tt2 = 0; tt2 < 2; ++tt2)
#pragma unroll
            for (int vv2 = 0; vv2 < 2; ++vv2) gbv[tt2][vv2] = __builtin_nontemporal_load((const u32x2*)(GBs + (crow + 16 * (2 * th + tt2) + fr) * D + hd * 128 + 16 * (2 * vq + vv2) + 4 * fq));
        { float off[2] = {1.f, 1.f}, pmid[2] = {1.f, 1.f}, plast[2] = {1.f, 1.f};
#pragma unroll
          for (int g = 0; g < 8; ++g) { const f32x2 t2 = *(const LAS f32x2*)(lds + HG_TOT + (g * 128 + d0) * 4);
              if (g < w) { off[0] *= t2.x; off[1] *= t2.y; }
              if (g < 4) { pmid[0] *= t2.x; pmid[1] *= t2.y; }
              plast[0] *= t2.x; plast[1] *= t2.y; }
          { const f32x2 t2 = *(const LAS f32x2*)(lds + HG_LF + d0 * 4); pmid[0] *= t2.x; pmid[1] *= t2.y; }
          float rpmid[2];
#pragma unroll
          for (int c = 0; c < 2; ++c) rpmid[c] = __builtin_amdgcn_rcpf(pmid[c]);
          if (w == 0) *(LAS f32x2*)(lds + HG_DEC + d0 * 4) = (f32x2){plast[0], plast[1]};
          float kst[8][2];
#pragma unroll
          for (int tt = 0; tt < 8; ++tt) {
              float qin[2], kin[2], qint[2];
#pragma unroll
              for (int c = 0; c < 2; ++c) {
                  const float Pt = off[c] * pf[tt][c], rP = __builtin_amdgcn_rcpf(Pt);
                  qint[c] = qh[tt][c] * Pt; qin[c] = qint[c] * rpmid[c];
                  const float kr = kk[tt][c] * rP; kin[c] = kr * pmid[c]; kst[tt][c] = kr * plast[c];
              }
              const int t = w * 8 + tt;
              *(LAS unsigned*)(lds + HG_QIN + t * 272 + d0 * 2) = cvt_pk_bf16(qin[0], qin[1]);
              *(LAS unsigned*)(lds + HG_KIN + t * 272 + d0 * 2) = cvt_pk_bf16(kin[0], kin[1]);
              *(LAS unsigned*)(lds + HG_QINT + t * 272 + d0 * 2) = cvt_pk_bf16(qint[0], qint[1]);
          }
#pragma unroll
          for (int c = 0; c < 2; ++c) {
              u32x4 pk, pv;
              pk.x = cvt_pk_bf16(kst[0][c], kst[1][c]); pk.y = cvt_pk_bf16(kst[2][c], kst[3][c]); pk.z = cvt_pk_bf16(kst[4][c], kst[5][c]); pk.w = cvt_pk_bf16(kst[6][c], kst[7][c]);
              pv.x = cvt_pk_bf16(vv[0][c], vv[1][c]); pv.y = cvt_pk_bf16(vv[2][c], vv[3][c]); pv.z = cvt_pk_bf16(vv[4][c], vv[5][c]); pv.w = cvt_pk_bf16(vv[6][c], vv[7][c]);
              *(LAS u32x4*)(lds + HG_KST + (d0 + c) * 144 + w * 16) = pk;
              *(LAS u32x4*)(lds + HG_VT + (d0 + c) * 144 + w * 16) = pv;
          } }
        __syncthreads();
        HG_PREP1(crow + 128)
        { bf16x8 yq[4];
#pragma unroll
          for (int ks = 0; ks < 4; ++ks) yq[ks] = lds_frag(lds + HG_QIN + (16 * ti + fr) * 272 + ks * 64 + fq * 16);
#pragma unroll
          for (int sjj = 0; sjj < 2; ++sjj) { const int sj = wh * 2 + sjj;
              f32x4 a = (f32x4){0.f, 0.f, 0.f, 0.f};
#pragma unroll
              for (int ks = 0; ks < 4; ++ks) a = __builtin_amdgcn_mfma_f32_16x16x32_bf16(lds_frag(lds + HG_KIN + (16 * sj + fr) * 272 + ks * 64 + fq * 16), yq[ks], a, 0, 0, 0);
              const int t = 16 * ti + fr, s0 = 16 * sj + 4 * fq;
#pragma unroll
              for (int j = 0; j < 4; ++j) a[j] = (s0 + j <= t) ? a[j] : 0.f;
              u32x2 pk; pk.x = cvt_pk_bf16(a[0], a[1]); pk.y = cvt_pk_bf16(a[2], a[3]);
              *(LAS u32x2*)(lds + HG_ATT + (16 * ti + fr) * 144 + (16 * sj + 4 * fq) * 2) = pk; } }
        f32x4 oa[2][2];
#pragma unroll
        for (int i = 0; i < 2; ++i) { oa[i][0] = (f32x4){0.f, 0.f, 0.f, 0.f}; oa[i][1] = oa[i][0]; }
#pragma unroll
        for (int ks = 0; ks < 4; ++ks) {
            bf16x8 yf[2], xf[2];
#pragma unroll
            for (int i = 0; i < 2; ++i) { yf[i] = lds_frag(lds + HG_QINT + (16 * (2 * th + i) + fr) * 272 + ks * 64 + fq * 16); xf[i] = lds_frag(lds + HG_ST + (16 * (2 * vq + i) + fr) * 272 + ks * 64 + fq * 16); }
#pragma unroll
            for (int tt2 = 0; tt2 < 2; ++tt2)
#pragma unroll
                for (int vv2 = 0; vv2 < 2; ++vv2) oa[tt2][vv2] = __builtin_amdgcn_mfma_f32_16x16x32_bf16(xf[vv2], yf[tt2], oa[tt2][vv2], 0, 0, 0);
        }
        __syncthreads();
#pragma unroll
        for (int ks = 0; ks < 2; ++ks) {
            bf16x8 yf[2], xf[2];
#pragma unroll
            for (int i = 0; i < 2; ++i) { yf[i] = lds_frag(lds + HG_ATT + (16 * (2 * th + i) + fr) * 144 + ks * 64 + fq * 16); xf[i] = lds_frag(lds + HG_VT + (16 * (2 * vq + i) + fr) * 144 + ks * 64 + fq * 16); }
#pragma unroll
            for (int tt2 = 0; tt2 < 2; ++tt2)
#pragma unroll
                for (int vv2 = 0; vv2 < 2; ++vv2) oa[tt2][vv2] = __builtin_amdgcn_mfma_f32_16x16x32_bf16(xf[vv2], yf[tt2], oa[tt2][vv2], 0, 0, 0);
        }
#pragma unroll
        for (int tt2 = 0; tt2 < 2; ++tt2) { float ss = 0.f;
#pragma unroll
            for (int vv2 = 0; vv2 < 2; ++vv2) ss += (oa[tt2][vv2][0] * oa[tt2][vv2][0] + oa[tt2][vv2][1] * oa[tt2][vv2][1]) + (oa[tt2][vv2][2] * oa[tt2][vv2][2] + oa[tt2][vv2][3] * oa[tt2][vv2][3]);
            ss += __shfl_xor(ss, 16); ss += __shfl_xor(ss, 32);
            if (fq == 0) *(LAS float*)(lds + HG_SSQ + (vq * 64 + 16 * (2 * th + tt2) + fr) * 4) = ss; }
#pragma unroll
        for (int dd = 0; dd < 4; ++dd) { const f32x4 dec = *(const LAS f32x4*)(lds + HG_DEC + (16 * (4 * th + dd) + 4 * fq) * 4);
            S[dd][0] = S[dd][0] * dec; S[dd][1] = S[dd][1] * dec; }
#pragma unroll
        for (int ks = 0; ks < 2; ++ks) {
            bf16x8 yv[2];
#pragma unroll
            for (int i = 0; i < 2; ++i) yv[i] = lds_frag(lds + HG_VT + (16 * (2 * vq + i) + fr) * 144 + ks * 64 + fq * 16);
#pragma unroll
            for (int dd = 0; dd < 4; ++dd) { const bf16x8 xk = lds_frag(lds + HG_KST + (16 * (4 * th + dd) + fr) * 144 + ks * 64 + fq * 16);
                S[dd][0] = __builtin_amdgcn_mfma_f32_16x16x32_bf16(xk, yv[0], S[dd][0], 0, 0, 0);
                S[dd][1] = __builtin_amdgcn_mfma_f32_16x16x32_bf16(xk, yv[1], S[dd][1], 0, 0, 0); }
        }
#pragma unroll
        for (int dd = 0; dd < 4; ++dd)
#pragma unroll
            for (int vv2 = 0; vv2 < 2; ++vv2) { const f32x4 sv = S[dd][vv2]; u32x2 pk; pk.x = cvt_pk_bf16(sv[0], sv[1]); pk.y = cvt_pk_bf16(sv[2], sv[3]);
                *(LAS u32x2*)(lds + HG_ST + (16 * (2 * vq + vv2) + fr) * 272 + (16 * (4 * th + dd) + 4 * fq) * 2) = pk; }
        __syncthreads();
#pragma unroll
        for (int tt2 = 0; tt2 < 2; ++tt2) { const int t = 16 * (2 * th + tt2) + fr;
            const float tot = (*(const LAS float*)(lds + HG_SSQ + t * 4) + *(const LAS float*)(lds + HG_SSQ + (64 + t) * 4)) + (*(const LAS float*)(lds + HG_SSQ + (128 + t) * 4) + *(const LAS float*)(lds + HG_SSQ + (192 + t) * 4));
            const float rstd = 1.0f / sqrtf(tot * (1.f / 128.f) + EPS);
#pragma unroll
            for (int vv2 = 0; vv2 < 2; ++vv2) {
                const size_t o = (crow + t) * D + hd * 128 + 16 * (2 * vq + vv2) + 4 * fq;
                const u32x2 g2 = gbv[tt2][vv2]; const f32x4 ov = oa[tt2][vv2];
                float g0 = bf_lo(g2.x), g1 = bf_hi(g2.x), g2f = bf_lo(g2.y), g3 = bf_hi(g2.y);
                if (!S1_SILU) { g0 = fsilu(g0); g1 = fsilu(g1); g2f = fsilu(g2f); g3 = fsilu(g3); }
                u32x2 pk; pk.x = cvt_pk_bf16(ov[0] * rstd * gn[vv2][0] * g0, ov[1] * rstd * gn[vv2][1] * g1);
                pk.y = cvt_pk_bf16(ov[2] * rstd * gn[vv2][2] * g2f, ov[3] * rstd * gn[vv2][3] * g3);
                *(u32x2*)(YB + o) = pk; } }
    }
    __syncthreads();
}

constexpr int LR_XCS = 0, LR_XCT = 17408, LR_GAT = 35840, LR_YAS = 54272;
__device__ __forceinline__ void lru_item(const Params& P, LAS unsigned char* lds, int b, int blk, int w, int l, bf16* YA) {
    const bf16* XA = (const bf16*)(P.ws + WS_XA); const bf16* GA = (const bf16*)(P.ws + WS_GA);
    const bf16* GBT = (const bf16*)(P.ws + WS_MISC + MS_GBT); const float* sp8 = (const float*)(P.ws + WS_MISC + MS_SP8);
    const int fr = l & 15, fq = l >> 4, c0 = 2 * l, chg = blk * 128;
    float cw[4][2], cb[2];
#pragma unroll
    for (int c = 0; c < 2; ++c) { cb[c] = P.conv_b[chg + c0 + c];
#pragma unroll
        for (int k = 0; k < 4; ++k) cw[k][c] = P.conv_w[k * D + chg + c0 + c]; }
    bf16x8 wfx[4], wfa[4];
#pragma unroll
    for (int ks = 0; ks < 4; ++ks) { const bf16* r = GBT + (size_t)(256 * blk + 16 * w + fr) * 256 + 128 * (blk & 1) + 32 * ks + 8 * fq;
        wfx[ks] = *(const bf16x8*)r; wfa[ks] = *(const bf16x8*)(r + 128 * 256); }
    const int ch = chg + 16 * w + fr;
    const float bxv = P.rg_bx[ch], bav = P.rg_ba[ch], spv = sp8[ch] * L2E;
    float hc = 0.f;
    const size_t row0 = (size_t)b * SEQ; const int col = chg + c0;
    unsigned rx[11], rg[8];
#pragma unroll
    for (int i = 0; i < 11; ++i) { const int tp = 8 * w + i - 3; rx[i] = (tp >= 0) ? *(const unsigned*)(XA + (row0 + tp) * D + col) : 0u; }
#pragma unroll
    for (int tt = 0; tt < 8; ++tt) rg[tt] = __builtin_nontemporal_load((const unsigned*)(GA + (row0 + 8 * w + tt) * D + col));
    __syncthreads();
    for (int n = 0; n < 32; ++n) {
        const size_t crow = row0 + (size_t)n * 64;
        float xc[8][2];
#pragma unroll
        for (int tt = 0; tt < 8; ++tt)
#pragma unroll
            for (int c = 0; c < 2; ++c) { float a = cb[c];
#pragma unroll
                for (int k = 0; k < 4; ++k) a += cw[k][c] * (c ? bf_hi(rx[tt + k]) : bf_lo(rx[tt + k]));
                xc[tt][c] = a; }
#pragma unroll
        for (int tt = 0; tt < 8; ++tt) *(LAS unsigned*)(lds + LR_XCS + (8 * w + tt) * 272 + c0 * 2) = cvt_pk_bf16(xc[tt][0], xc[tt][1]);
#pragma unroll
        for (int c = 0; c < 2; ++c) {
            u32x4 px, pg;
            px.x = cvt_pk_bf16(xc[0][c], xc[1][c]); px.y = cvt_pk_bf16(xc[2][c], xc[3][c]); px.z = cvt_pk_bf16(xc[4][c], xc[5][c]); px.w = cvt_pk_bf16(xc[6][c], xc[7][c]);
            if (c == 0) { pg.x = (rg[0] & 0xffffu) | (rg[1] << 16); pg.y = (rg[2] & 0xffffu) | (rg[3] << 16); pg.z = (rg[4] & 0xffffu) | (rg[5] << 16); pg.w = (rg[6] & 0xffffu) | (rg[7] << 16); }
            else        { pg.x = (rg[0] >> 16) | (rg[1] & 0xffff0000u); pg.y = (rg[2] >> 16) | (rg[3] & 0xffff0000u); pg.z = (rg[4] >> 16) | (rg[5] & 0xffff0000u); pg.w = (rg[6] >> 16) | (rg[7] & 0xffff0000u); }
            *(LAS u32x4*)(lds + LR_XCT + (c0 + c) * 144 + w * 16) = px;
            *(LAS u32x4*)(lds + LR_GAT + (c0 + c) * 144 + w * 16) = pg;
        }
        { const size_t nrow = (n < 31) ? crow + 64 : crow;
#pragma unroll
            for (int i = 0; i < 11; ++i) rx[i] = *(const unsigned*)(XA + (nrow + 8 * w + i - 3) * D + col);
#pragma unroll
            for (int tt = 0; tt < 8; ++tt) rg[tt] = __builtin_nontemporal_load((const unsigned*)(GA + (nrow + 8 * w + tt) * D + col));
        }
        __syncthreads();
        f32x4 ax[4], aa[4];
#pragma unroll
        for (int tj = 0; tj < 4; ++tj) { ax[tj] = (f32x4){0.f, 0.f, 0.f, 0.f}; aa[tj] = ax[tj];
#pragma unroll
            for (int ks = 0; ks < 4; ++ks) { const bf16x8 xf = lds_frag(lds + LR_XCS + (16 * tj + fr) * 272 + ks * 64 + fq * 16);
                ax[tj] = __builtin_amdgcn_mfma_f32_16x16x32_bf16(xf, wfx[ks], ax[tj], 0, 0, 0);
                aa[tj] = __builtin_amdgcn_mfma_f32_16x16x32_bf16(xf, wfa[ks], aa[tj], 0, 0, 0); } }
#pragma unroll
        for (int tj = 0; tj < 4; ++tj) {
            const u32x2 xp = *(const LAS u32x2*)(lds + LR_XCT + (16 * w + fr) * 144 + (16 * tj + 4 * fq) * 2);
            const u32x2 gp = *(const LAS u32x2*)(lds + LR_GAT + (16 * w + fr) * 144 + (16 * tj + 4 * fq) * 2);
            const float xv[4] = {bf_lo(xp.x), bf_hi(xp.x), bf_lo(xp.y), bf_hi(xp.y)}, gv[4] = {bf_lo(gp.x), bf_hi(gp.x), bf_lo(gp.y), bf_hi(gp.y)};
            float hl[4], Ac[4];
#pragma unroll
            for (int j = 0; j < 4; ++j) {
                const float gi = fsigmoid(ax[tj][j] + bxv), gr = fsigmoid(aa[tj][j] + bav);
                const float a = __builtin_amdgcn_exp2f(-gr * spv);
                const float u = __builtin_amdgcn_sqrtf(fmaxf(1.0f - a * a, 0.f)) * gi * xv[j];
                hl[j] = j ? a * hl[j - 1] + u : u; Ac[j] = j ? a * Ac[j - 1] : a;
            }
            float Ag = Ac[3], Hg = hl[3];
            { const float A1 = __shfl_up(Ag, 16), H1 = __shfl_up(Hg, 16); if (fq >= 1) { Hg = Ag * H1 + Hg; Ag = Ag * A1; } }
            { const float A2 = __shfl_up(Ag, 32), H2 = __shfl_up(Hg, 32); if (fq >= 2) { Hg = Ag * H2 + Hg; Ag = Ag * A2; } }
            float Ae = __shfl_up(Ag, 16), He = __shfl_up(Hg, 16); if (fq == 0) { Ae = 1.f; He = 0.f; }
            const float At = __shfl(Ag, 48 + fr), Ht = __shfl(Hg, 48 + fr);
            const float hstart = Ae * hc + He;
#pragma unroll
            for (int j = 0; j < 4; ++j) { const float y = (hl[j] + Ac[j] * hstart) * fsilu(gv[j]);
                *(LAS unsigned short*)(lds + LR_YAS + (16 * tj + 4 * fq + j) * 272 + (16 * w + fr) * 2) = (unsigned short)(cvt_pk_bf16(y, 0.f) & 0xffffu); }
            hc = At * hc + Ht;
        }
        asm volatile("s_waitcnt vmcnt(0)" ::: "memory");
        __syncthreads();
#pragma unroll
        for (int tt = 0; tt < 8; ++tt) *(unsigned*)(YA + (crow + 8 * w + tt) * D + col) = *(const LAS unsigned*)(lds + LR_YAS + (8 * w + tt) * 272 + c0 * 2);
    }
    __syncthreads();
}

#define XB_TMO      128
#define XB_XCNT(j)  (256  + 64 * (j))
#define XB_XSUB(j)  (1280 + 64 * (j))
#define XB_XGEN(j)  (2304 + 64 * (j))
#define XB_TOP      3328
#define XB_TOPGEN   3392
#define XCD_BAR_WORDS 3456
#define XB_SPIN_CAP (1u << 18)

__device__ __forceinline__ unsigned xb_ld(unsigned* p)              { return __hip_atomic_load(p, __ATOMIC_RELAXED, __HIP_MEMORY_SCOPE_AGENT); }
__device__ __forceinline__ unsigned xb_add(unsigned* p, unsigned v) { return __hip_atomic_fetch_add(p, v, __ATOMIC_RELAXED, __HIP_MEMORY_SCOPE_AGENT); }
__device__ __forceinline__ unsigned xb_xcc_id() { return (unsigned)__builtin_amdgcn_s_getreg((3 << 11) | 20) & 0xFu; }
#define XB_SPIN(cond, bar) do { unsigned _sp = 0; while (cond) { __builtin_amdgcn_s_sleep(1); \
    if ((++_sp & 255u) == 0u) { if (xb_ld(&(bar)[XB_TMO])) break; if (_sp > XB_SPIN_CAP) { atomicAdd(&(bar)[XB_TMO], 1u); break; } } } } while (0)

struct XcdBarrier {
    unsigned* bar; unsigned x;
    volatile LAS unsigned* st;
};

__device__ __forceinline__ XcdBarrier xcd_barrier_post(unsigned* bar, volatile LAS unsigned* st) {
    XcdBarrier b; b.bar = bar; b.x = xb_xcc_id(); b.st = st;
    if (threadIdx.x == 0) (void)xb_add(&bar[XB_XCNT(b.x)], 1u);
    return b;
}
__device__ __forceinline__ void xcd_barrier_complete(unsigned* bar, unsigned x, unsigned& nloc, unsigned& nx) {
    const unsigned G = gridDim.x * gridDim.y * gridDim.z;
    unsigned sum, cnt, mine, sp = 0u;
    for (;;) {
        sum = 0u; cnt = 0u; mine = 0u;
#pragma unroll
        for (unsigned j = 0; j < 16; ++j) { const unsigned c = xb_ld(&bar[XB_XCNT(j)]); sum += c; cnt += (c > 0u) ? 1u : 0u; mine = (j == x) ? c : mine; }
        if (sum == G) break;
        __builtin_amdgcn_s_sleep(1);
        if ((++sp & 255u) == 0u) { if (xb_ld(&bar[XB_TMO])) break; if (sp > XB_SPIN_CAP) { atomicAdd(&bar[XB_TMO], 1u); break; } }
    }
    nloc = mine > 0u ? mine : 1u; nx = cnt > 0u ? cnt : 1u;
}

__device__ __forceinline__ void xcd_barrier(const XcdBarrier& b) {
    asm volatile("s_waitcnt vmcnt(0)" ::: "memory");
    __syncthreads();
    if (threadIdx.x == 0) {
        unsigned* bar = b.bar;
        __builtin_amdgcn_s_waitcnt(0);
        unsigned nloc = b.st[0], nx = b.st[1];
        if (nloc == 0u) { xcd_barrier_complete(bar, b.x, nloc, nx); b.st[0] = nloc; b.st[1] = nx; }
        const unsigned old = xb_add(&bar[XB_XSUB(b.x)], 1u);
        const unsigned gen = old / nloc;
        if (old + 1u == (gen + 1u) * nloc) {
            __builtin_amdgcn_fence(__ATOMIC_RELEASE, "agent");
            asm volatile("s_waitcnt vmcnt(0)" ::: "memory");
            const unsigned og = xb_add(&bar[XB_TOP], 1u);
            const unsigned tg = og / nx;
            if (og + 1u == (tg + 1u) * nx) xb_add(&bar[XB_TOPGEN], 1u);
            else XB_SPIN(xb_ld(&bar[XB_TOPGEN]) == tg, bar);
            __builtin_amdgcn_fence(__ATOMIC_ACQUIRE, "agent");
            xb_add(&bar[XB_XGEN(b.x)], 1u);
            asm volatile("s_waitcnt vmcnt(0)" ::: "memory");
        } else {
            XB_SPIN(xb_ld(&bar[XB_XGEN(b.x)]) == gen, bar);
            __builtin_amdgcn_fence(__ATOMIC_ACQUIRE, "agent");
            asm volatile("s_waitcnt vmcnt(0)" ::: "memory");
        }
    }
    __syncthreads();
}


constexpr int P6A_LRU_TILES = 3;
__global__ void __launch_bounds__(512, 2) hawk_hgrn2_fwd(Params P) {
    extern __shared__ __attribute__((aligned(16))) unsigned char lds_raw[];
    LAS unsigned char* lds = (LAS unsigned char*)lds_raw;
    cg::grid_group grid = cg::this_grid();
#define GRID_SYNC() xcd_barrier(xbar_)
#define PHASE_IDS() int tid = threadIdx.x; asm volatile("" : "+v"(tid)); const int lane = tid & 63, wave = __builtin_amdgcn_readfirstlane(tid >> 6); (void)lane; (void)wave
    const int G = gridDim.x;
    volatile LAS unsigned* xst_ = (volatile LAS unsigned*)(lds + (LDS_BYTES - 64));
    if (threadIdx.x < 16) xst_[threadIdx.x] = 0u;
    __syncthreads();
    const XcdBarrier xbar_ = xcd_barrier_post(P.bar, xst_);
    unsigned char* ws = P.ws; unsigned char* ms = ws + WS_MISC;
    bf16* const dH = (bf16*)(ws + WS_H); bf16* const dXA = (bf16*)(ws + WS_XA); bf16* const dGA = (bf16*)(ws + WS_GA); bf16* const dQ = (bf16*)(ws + WS_Q);
    bf16* const dF = (bf16*)(ws + WS_F); bf16* const dI = (bf16*)(ws + WS_I);
    bf16* const dGMA0 = (bf16*)P.out; bf16* const dGMB0 = (bf16*)P.out + (size_t)M * D;
    const bf16* WinT = (const bf16*)(ms + MS_WIN);

    if (P.use_cg_sync) grid.sync();
    { PHASE_IDS(); p0_prologue(P, lds, wave, lane); }
    GRID_SYNC();
    { pg8::Gemm g{dH, WinT, M, 8192, D, D, 0, 0};
      pg8::EpiBf16<2> E{dXA, (size_t)M * D, nullptr, P.b_merge, dGMA0, dGMB0};
      { pg8::StaticOrder S; S.init(M, 8192, G, (int)blockIdx.x); pg8::gemm_phase<pg8::EpiBf16<2>, pg8::StaticOrder, true, true>(lds, g, S, E); }
    }
    GRID_SYNC();
    { const int nh = G / 2;
      PHASE_IDS();
      if ((int)blockIdx.x < nh) {
        for (int it = blockIdx.x; it < NB * NHEAD; it += nh) hgrn_item2(P, lds, it >> 3, it & 7, wave, lane, dQ);
        { __syncthreads();
          if (threadIdx.x == 0) { unsigned* hb = P.bar + 3840 + 16 * ((int)blockIdx.x >> 3); unsigned sp = 0;
              while (__hip_atomic_load(hb, __ATOMIC_RELAXED, __HIP_MEMORY_SCOPE_AGENT) < 8u && ++sp < (1u << 22)) __builtin_amdgcn_s_sleep(2);
              __builtin_amdgcn_fence(__ATOMIC_ACQUIRE, "agent"); asm volatile("s_waitcnt vmcnt(0)" ::: "memory"); }
          __syncthreads(); }
        { pg8::Gemm g{dXA, (const bf16*)(ms + MS_PA), M, D, D, D, 0, 0}; pg8::ColOrder S{(int)blockIdx.x, P6A_LRU_TILES, 4 - P6A_LRU_TILES};
          pg8::EpiGate<0> E{dGMA0, nullptr, dH, P.b_merge};
          pg8::gemm_phase<pg8::EpiGate<0>, pg8::ColOrder, true, true>(lds, g, S, E); } }
      else {
        for (int it = (int)blockIdx.x - nh; it < NB * 8; it += G - nh) lru_item(P, lds, it >> 3, it & 7, wave, lane, dXA);
        { asm volatile("s_waitcnt vmcnt(0) lgkmcnt(0)" ::: "memory"); __syncthreads();
          if (threadIdx.x == 0) { __builtin_amdgcn_fence(__ATOMIC_RELEASE, "agent"); asm volatile("s_waitcnt vmcnt(0)" ::: "memory");
              unsigned* hb = P.bar + 3840 + 16 * (((int)blockIdx.x - nh) >> 3);
              __hip_atomic_fetch_add(hb, 1u, __ATOMIC_RELAXED, __HIP_MEMORY_SCOPE_AGENT);
              unsigned sp = 0; while (__hip_atomic_load(hb, __ATOMIC_RELAXED, __HIP_MEMORY_SCOPE_AGENT) < 8u && ++sp < (1u << 22)) __builtin_amdgcn_s_sleep(2);
              __builtin_amdgcn_fence(__ATOMIC_ACQUIRE, "agent"); asm volatile("s_waitcnt vmcnt(0)" ::: "memory"); }
          __syncthreads(); }
        { pg8::Gemm g{dXA, (const bf16*)(ms + MS_PA), M, D, D, D, 0, 0}; pg8::ColOrder S{(int)blockIdx.x - nh, 0, P6A_LRU_TILES};
          pg8::EpiGate<0> E{dGMA0, nullptr, dH, P.b_merge};
          pg8::gemm_phase<pg8::EpiGate<0>, pg8::ColOrder, true, true>(lds, g, S, E); } } }
    GRID_SYNC();
    { pg8::Gemm g{dQ, (const bf16*)(ms + MS_PB), M, D, D, D, 0, 0}; pg8::PanelOrder S; S.init(M, G, (int)blockIdx.x);
      pg8::EpiGate<1> E{dGMB0, dH, dF, P.b_merge + D};
      pg8::gemm_phase<pg8::EpiGate<1>, pg8::PanelOrder, true, true>(lds, g, S, E); }
    GRID_SYNC();
    { pg8::Gemm g{dF, (const bf16*)(ms + MS_WO), M, D, D, D, 0, 0}; pg8::PanelOrder S; S.init(M, G, (int)blockIdx.x);
      pg8::EpiFinal E{P.x, P.out, P.final_g, (float*)(ms + MS_PART), (unsigned*)(ms + MS_CNT), lds + 131072};
      pg8::gemm_phase<pg8::EpiFinal, pg8::PanelOrder, true, true>(lds, g, S, E); }
}

extern "C" void kernel_launch(void* const* d_in, const int* in_sizes, int n_in, void* d_out, int out_size, void* d_ws, size_t ws_size, hipStream_t stream) {
    static int grid = 0;
    if (!grid) {
        if (n_in != 17 || in_sizes[0] != M * D || out_size != M * D || ws_size < WS_NEED) {
            fprintf(stderr, "kernel_launch: unexpected shapes: n_in %d in0 %d out %d ws %zu (need %zu); nothing launched\n", n_in, n_in > 0 ? in_sizes[0] : -1, out_size, ws_size, (size_t)WS_NEED); grid = -1; return; }
        int dev = 0, cus = 0, per_cu = 0;
        if (hipGetDevice(&dev) != hipSuccess || hipDeviceGetAttribute(&cus, hipDeviceAttributeMultiprocessorCount, dev) != hipSuccess) { grid = -1; return; }
        if (hipFuncSetAttribute((const void*)hawk_hgrn2_fwd, hipFuncAttributeMaxDynamicSharedMemorySize, LDS_BYTES) != hipSuccess) { fprintf(stderr, "kernel_launch: hipFuncSetAttribute failed\n"); grid = -1; return; }
        if (hipOccupancyMaxActiveBlocksPerMultiprocessor(&per_cu, (const void*)hawk_hgrn2_fwd, 512, LDS_BYTES) != hipSuccess || per_cu < 1) { fprintf(stderr, "kernel_launch: occupancy query says %d\n", per_cu); }
        if (cus < 256) { fprintf(stderr, "kernel_launch: this build needs 256 co-resident workgroups (one per CU); the device has %d CUs; nothing launched\n", cus); grid = -1; return; }
        grid = 256;
    }
    if (grid <= 0) return;
    Params p{};
    p.x = (const float*)d_in[0]; p.w_in = (const float*)d_in[1]; p.b_merge = (const float*)d_in[2]; p.conv_w = (const float*)d_in[3]; p.conv_b = (const float*)d_in[4];
    p.rg_wx = (const float*)d_in[5]; p.rg_bx = (const float*)d_in[6]; p.rg_wa = (const float*)d_in[7]; p.rg_ba = (const float*)d_in[8]; p.rg_lambda = (const float*)d_in[9];
    p.hg_lb = (const float*)d_in[10]; p.hg_norm_g = (const float*)d_in[11]; p.proj_a = (const float*)d_in[12]; p.proj_b = (const float*)d_in[13]; p.w_out = (const float*)d_in[14];
    p.norm_g = (const float*)d_in[15]; p.final_g = (const float*)d_in[16];
    p.out = (float*)d_out; p.ws = (unsigned char*)d_ws; p.bar = (unsigned*)((unsigned char*)d_ws + WS_MISC + MS_BAR); p.use_cg_sync = 0; p.pad = 0;
    if (hipMemsetAsync(p.bar, 0, 16384, stream) != hipSuccess) { fprintf(stderr, "kernel_launch: memset failed\n"); return; }
    void* args[] = {&p};
    hipError_t e = hipLaunchCooperativeKernel((const void*)hawk_hgrn2_fwd, dim3(grid), dim3(512), args, LDS_BYTES, stream);
    if (e != hipSuccess) fprintf(stderr, "kernel_launch: cooperative launch failed: %s (grid %d)\n", hipGetErrorString(e), grid);
}
```
